# Optimizing an MI355X kernel written in HIP

```python
import jax
import jax.numpy as jnp
from jax import lax
import numpy as np

D_MODEL = 1024
BATCH = 16
SEQ = 2048
DEPTH = 4

GRID_W = 64
CTX_LEN = 256
HEAD_DIM = 64
NA_HEADS = 6
NA_WIN_ROWS = 8
NA_WIN_COLS = 16
GQA_HEADS = 6
GQA_KV_HEADS = 2
Q_BLOCK = 128
ROPE_THETA = 10000.0
HG_HEADS = 4
HG_CHUNK = 64
LB_FLOOR = 1e-30
WA = NA_HEADS * HEAD_DIM
WB = GQA_HEADS * HEAD_DIM
WKV = GQA_KV_HEADS * HEAD_DIM
WC = HG_HEADS * HEAD_DIM
MIX_WIDTH = WA + WB + WC
COL_LAYOUT = (('a_k', WA), ('a_v', WA), ('b_k', WKV), ('b_v', WKV), ('c_f', WC), ('c_b', WC), ('c_i', WC),
              ('a_q', WA), ('b_q', WB), ('c_q', WC), ('c_g', WC))
KEY_SIDE_COLS = 2 * WA + 2 * WKV + 3 * WC
IN_COLS = KEY_SIDE_COLS + WA + WB + 2 * WC
D_FF = 2816
CONV_W = 3
N_MOD = 6
DEEPNORM_ALPHA = (2.0 * DEPTH) ** 0.25
DEEPNORM_BETA = (8.0 * DEPTH) ** -0.25
LN_EPS = 1e-6
RMS_EPS = 1e-6

kernel_name = 'hybrid_natten_gqa_hgrn2_dit_block'


def layer_norm(x, g=None, b=None):
    xf = x.astype(jnp.float32)
    mu = jnp.mean(xf, -1, keepdims=True)
    var = jnp.mean(jnp.square(xf - mu), -1, keepdims=True)
    y = (xf - mu) * lax.rsqrt(var + LN_EPS)
    if g is not None:
        y = y * g.astype(jnp.float32) + b.astype(jnp.float32)
    return y.astype(x.dtype)


def rms_norm(x, g):
    xf = x.astype(jnp.float32)
    y = xf * lax.rsqrt(jnp.mean(jnp.square(xf), -1, keepdims=True) + RMS_EPS)
    return (y * g.astype(jnp.float32)).astype(x.dtype)


def modulate(x, shift, scale):
    return layer_norm(x) * (1 + scale) + shift


def split_heads(t):
    return t.reshape(t.shape[0], t.shape[1], -1, HEAD_DIM)


def split_projection(y):
    parts, off = {}, 0
    for name, width in COL_LAYOUT:
        if off + width > y.shape[-1]:
            break
        parts[name] = split_heads(y[..., off:off + width])
        off += width
    return parts


def axial_rope_tables(n):
    t = jnp.arange(n)
    pos = jnp.stack([t // GRID_W, t % GRID_W]).astype(jnp.float32)
    n_freq = HEAD_DIM // 4
    inv_freq = ROPE_THETA ** (-jnp.arange(n_freq, dtype=jnp.float32) / n_freq)
    ang = pos[:, :, None] * inv_freq
    return jnp.cos(ang), jnp.sin(ang)


def apply_axial_rope(x, cos, sin):
    B, T, H, d = x.shape
    xs = x.reshape(B, T, H, 2, 2, d // 4)
    cos = jnp.swapaxes(cos, 0, 1)[:, None].astype(x.dtype)
    sin = jnp.swapaxes(sin, 0, 1)[:, None].astype(x.dtype)
    x1, x2 = xs[..., 0, :], xs[..., 1, :]
    out = jnp.stack([x1 * cos - x2 * sin, x2 * cos + x1 * sin], axis=-2)
    return out.reshape(B, T, H, d)


def block_attention(q, k, v):
    B, T, Hq, d = q.shape
    Hkv = k.shape[2]
    G = Hq // Hkv
    scale = d ** -0.5
    qb = q.reshape(B, T // Q_BLOCK, Q_BLOCK, Hkv, G, d).transpose(1, 0, 2, 3, 4, 5)

    def one_block(q_blk):
        s = jnp.einsum('bqkgd,bskd->bkgqs', q_blk, k).astype(jnp.float32) * scale
        p = jax.nn.softmax(s, axis=-1).astype(v.dtype)
        return jnp.einsum('bkgqs,bskd->bqkgd', p, v)

    o = lax.map(one_block, qb)
    return o.transpose(1, 0, 2, 3, 4, 5).reshape(B, T, Hq * d)


def neighbourhood_attention(q, k, v, k_ctx, v_ctx, rpb):
    B, N, H, d = q.shape
    rows = N // GRID_W
    kr = min(NA_WIN_ROWS, rows)
    kc = NA_WIN_COLS
    n_loc = kr * kc
    scale = d ** -0.5
    cols = np.arange(GRID_W)
    col_start = np.clip(cols - kc // 2, 0, GRID_W - kc)
    col_idx = (col_start[:, None] + np.arange(kc)[None, :]).astype(np.int32)
    dc_idx = (col_idx - cols[:, None] + (NA_WIN_COLS - 1)).astype(np.int32)
    kg = k.reshape(B, rows, GRID_W, H, d)
    vg = v.reshape(B, rows, GRID_W, H, d)
    qg = q.reshape(B, rows, GRID_W, H, d).transpose(1, 0, 2, 3, 4)

    def one_row(args):
        r, q_row = args
        r_start = jnp.clip(r - kr // 2, 0, rows - kr)
        k_nb = lax.dynamic_slice_in_dim(kg, r_start, kr, axis=1)[:, :, col_idx]
        v_nb = lax.dynamic_slice_in_dim(vg, r_start, kr, axis=1)[:, :, col_idx]
        dr_idx = r_start + jnp.arange(kr) - r + (NA_WIN_ROWS - 1)
        bias = rpb[:, dr_idx[:, None, None], dc_idx[None]]
        s_loc = (jnp.einsum('bwhd,brwjhd->bhwrj', q_row, k_nb).astype(jnp.float32) * scale
                 + bias.transpose(0, 2, 1, 3).astype(jnp.float32))
        s_ctx = jnp.einsum('bwhd,blhd->bhwl', q_row, k_ctx).astype(jnp.float32) * scale
        s = jnp.concatenate([s_loc.reshape(B, H, GRID_W, n_loc), s_ctx], axis=-1)
        p = jax.nn.softmax(s, axis=-1).astype(v.dtype)
        p_loc = p[..., :n_loc].reshape(B, H, GRID_W, kr, kc)
        return (jnp.einsum('bhwrj,brwjhd->bwhd', p_loc, v_nb)
                + jnp.einsum('bhwl,blhd->bwhd', p[..., n_loc:], v_ctx))

    o = lax.map(one_row, (jnp.arange(rows), qg))
    return o.transpose(1, 0, 2, 3, 4).reshape(B, N, H * d)


def forget_log(z, lb):
    lb = lb.astype(jnp.float32)
    return jnp.logaddexp(jnp.log(jnp.maximum(lb, LB_FLOOR)),
                         jnp.log1p(-lb) + jax.nn.log_sigmoid(z.astype(jnp.float32)))


def gla_chunkwise(q, k, v, logf, s0):
    B, T, H, dk = q.shape
    C = HG_CHUNK
    n = T // C

    def to_chunks(a):
        return a.reshape(B, n, C, H, a.shape[-1]).transpose(1, 0, 3, 2, 4)

    causal = jnp.tril(jnp.ones((C, C), bool))[:, :, None]

    def step(S, inp):
        qc, kc, vc, gc = inp
        b = jnp.cumsum(gc, axis=-2)
        diff = b[..., :, None, :] - b[..., None, :, :]
        decay = jnp.where(causal, jnp.exp(jnp.where(causal, diff, 0.0)), 0.0)
        att = jnp.einsum('bhtk,bhsk,bhtsk->bhts', qc, kc, decay)
        o = jnp.einsum('bhts,bhsv->bhtv', att, vc) + jnp.einsum('bhtk,bhkv->bhtv', qc * jnp.exp(b), S)
        b_last = b[..., -1:, :]
        S = S * jnp.exp(b_last[..., 0, :])[..., None] + jnp.einsum('bhsk,bhsv->bhkv', kc * jnp.exp(b_last - b), vc)
        return S, o

    S, o = lax.scan(step, s0, (to_chunks(q), to_chunks(k), to_chunks(v), to_chunks(logf)))
    o = o.transpose(1, 0, 3, 2, 4).reshape(B, T, H, v.shape[-1])
    return o.astype(v.dtype), S


def hgrn2_scan(q, v, logf, s0, reverse):
    k = -jnp.expm1(logf)
    if reverse:
        q, k, v, logf = (jnp.flip(a, axis=1) for a in (q, k, v, logf))
    o, s = gla_chunkwise(q, k, v, logf, s0)
    if reverse:
        o = jnp.flip(o, axis=1)
    return o, s


def hgrn2_final_state(v, logf, reverse):
    k = -jnp.expm1(logf)
    if reverse:
        k, v, logf = (jnp.flip(a, axis=1) for a in (k, v, logf))
    suffix = lax.cumsum(logf, axis=1, reverse=True) - logf
    return jnp.einsum('bthk,bthv->bhkv', k * jnp.exp(suffix), v)


def hgrn2_readout(o, g, gn_g):
    y = rms_norm(o, gn_g) * jax.nn.silu(g)
    return y.reshape(y.shape[0], y.shape[1], WC)


def token_mixer(h, hc, w_in, w_out, rpb, q_g, k_g, lb, gn_g, rope_cos, rope_sin, with_ctx_out):
    lat = split_projection(h @ w_in)
    ctx = split_projection(hc @ (w_in if with_ctx_out else w_in[:, :KEY_SIDE_COLS]))
    o_a = neighbourhood_attention(lat['a_q'], lat['a_k'], lat['a_v'], ctx['a_k'], ctx['a_v'], rpb)
    kc_b = rms_norm(ctx['b_k'], k_g)
    q_b = apply_axial_rope(rms_norm(lat['b_q'], q_g), rope_cos, rope_sin)
    k_b = jnp.concatenate([kc_b, apply_axial_rope(rms_norm(lat['b_k'], k_g), rope_cos, rope_sin)], axis=1)
    v_b = jnp.concatenate([ctx['b_v'], lat['b_v']], axis=1)
    o_b = block_attention(q_b, k_b, v_b)
    lb_f = lb[0].reshape(HG_HEADS, HEAD_DIM)
    lb_b = lb[1].reshape(HG_HEADS, HEAD_DIM)
    q_scale = HEAD_DIM ** -0.5
    logf_cf = forget_log(ctx['c_f'], lb_f)
    logf_cb = forget_log(ctx['c_b'], lb_b)
    if with_ctx_out:
        zero = jnp.zeros((hc.shape[0], HG_HEADS, HEAD_DIM, HEAD_DIM), jnp.float32)
        qc_c = ctx['c_q'] * q_scale
        oc_f, s_f = hgrn2_scan(qc_c, ctx['c_i'], logf_cf, zero, False)
        oc_bw, s_b = hgrn2_scan(qc_c, ctx['c_i'], logf_cb, zero, True)
    else:
        s_f = hgrn2_final_state(ctx['c_i'], logf_cf, False)
        s_b = hgrn2_final_state(ctx['c_i'], logf_cb, True)
    q_c = lat['c_q'] * q_scale
    o_f, _ = hgrn2_scan(q_c, lat['c_i'], forget_log(lat['c_f'], lb_f), s_f, False)
    o_bw, _ = hgrn2_scan(q_c, lat['c_i'], forget_log(lat['c_b'], lb_b), s_b, True)
    o_c = hgrn2_readout(o_f + o_bw, lat['c_g'], gn_g)
    y = jnp.concatenate([o_a, o_b, o_c], axis=-1) @ w_out
    if not with_ctx_out:
        return y, None
    oc_a = block_attention(ctx['a_q'], ctx['a_k'], ctx['a_v'])
    oc_b = block_attention(rms_norm(ctx['b_q'], q_g), kc_b, ctx['b_v'])
    oc_c = hgrn2_readout(oc_f + oc_bw, ctx['c_g'], gn_g)
    yc = jnp.concatenate([oc_a, oc_b, oc_c], axis=-1) @ w_out
    return y, yc


def conv_ffn(h, w_up, conv_w, conv_b, w_down):
    T = h.shape[1]
    u = h @ w_up
    up = jnp.pad(u, ((0, 0), (CONV_W // 2, CONV_W // 2), (0, 0)))
    u = sum(up[:, j:j + T] * conv_w[j] for j in range(CONV_W)) + conv_b
    gate, val = jnp.split(u, 2, axis=-1)
    return (jax.nn.silu(gate) * val) @ w_down


def setup_inputs(seed: int = 0) -> dict:
    key = jax.random.key(seed)
    ks = jax.random.split(key, 21)

    def nrm(k, shape, scale):
        return jax.random.normal(k, shape, jnp.float32) * scale

    D = D_MODEL
    return {
        'x': nrm(ks[0], (BATCH, SEQ, D), 1.0),
        'c': nrm(ks[1], (BATCH, D), 1.0),
        'ctx': nrm(ks[2], (BATCH, CTX_LEN, D), 1.0),
        'c_ctx': nrm(ks[3], (D,), 1.0),
        'w_ada': nrm(ks[4], (DEPTH, D, N_MOD * D), 0.5 * D ** -0.5),
        'b_ada': nrm(ks[5], (DEPTH, N_MOD * D), 0.02),
        'w_in': nrm(ks[6], (DEPTH, D, IN_COLS), D ** -0.5),
        'w_out': nrm(ks[7], (DEPTH, MIX_WIDTH, D), DEEPNORM_BETA * MIX_WIDTH ** -0.5),
        'na_rpb': nrm(ks[8], (DEPTH, NA_HEADS, 2 * NA_WIN_ROWS - 1, 2 * NA_WIN_COLS - 1), 0.1),
        'q_norm': 1.0 + nrm(ks[9], (DEPTH, HEAD_DIM), 0.02),
        'k_norm': 1.0 + nrm(ks[10], (DEPTH, HEAD_DIM), 0.02),
        'hg_lower_bound': 1.0 + nrm(ks[11], (DEPTH, 2, WC), 0.1),
        'hg_norm': 1.0 + nrm(ks[12], (DEPTH, HEAD_DIM), 0.02),
        'ln1_g': 1.0 + nrm(ks[13], (DEPTH, D), 0.02),
        'ln1_b': nrm(ks[14], (DEPTH, D), 0.02),
        'w_up': nrm(ks[15], (DEPTH, D, 2 * D_FF), D ** -0.5),
        'conv_w': nrm(ks[16], (DEPTH, CONV_W, 2 * D_FF), CONV_W ** -0.5),
        'conv_b': nrm(ks[17], (DEPTH, 2 * D_FF), 0.02),
        'w_down': nrm(ks[18], (DEPTH, D_FF, D), DEEPNORM_BETA * D_FF ** -0.5),
        'ln2_g': 1.0 + nrm(ks[19], (DEPTH, D), 0.02),
        'ln2_b': nrm(ks[20], (DEPTH, D), 0.02),
    }


def reference(x, c, ctx, c_ctx, w_ada, b_ada, w_in, w_out, na_rpb, q_norm, k_norm, hg_lower_bound, hg_norm,
              ln1_g, ln1_b, w_up, conv_w, conv_b, w_down, ln2_g, ln2_b):
    s_c = jax.nn.silu(c)
    s_cc = jax.nn.silu(c_ctx)
    lb = jax.nn.softmax(hg_lower_bound.astype(jnp.float32), axis=0)
    lb = jnp.cumsum(lb, axis=0) - lb[0]
    rope_cos, rope_sin = axial_rope_tables(x.shape[1])
    xc = ctx
    for l in range(DEPTH):
        last = l == DEPTH - 1
        mod = jnp.split((s_c @ w_ada[l] + b_ada[l])[:, None, :], N_MOD, axis=-1)
        n_ctx_mod = 2 if last else N_MOD
        mod_c = jnp.split(s_cc @ w_ada[l, :, :n_ctx_mod * D_MODEL] + b_ada[l, :n_ctx_mod * D_MODEL],
                          n_ctx_mod, axis=-1)
        h = modulate(x, mod[0], mod[1])
        hc = modulate(xc, mod_c[0], mod_c[1])
        y, yc = token_mixer(h, hc, w_in[l], w_out[l], na_rpb[l], q_norm[l], k_norm[l], lb[l], hg_norm[l],
                            rope_cos, rope_sin, not last)
        x = layer_norm(DEEPNORM_ALPHA * x + mod[2] * y, ln1_g[l], ln1_b[l])
        f = conv_ffn(modulate(x, mod[3], mod[4]), w_up[l], conv_w[l], conv_b[l], w_down[l])
        x = layer_norm(DEEPNORM_ALPHA * x + mod[5] * f, ln2_g[l], ln2_b[l])
        if not last:
            xc = layer_norm(DEEPNORM_ALPHA * xc + mod_c[2] * yc, ln1_g[l], ln1_b[l])
            fc = conv_ffn(modulate(xc, mod_c[3], mod_c[4]), w_up[l], conv_w[l], conv_b[l], w_down[l])
            xc = layer_norm(DEEPNORM_ALPHA * xc + mod_c[5] * fc, ln2_g[l], ln2_b[l])
    return x
```

```cpp
#include <hip/hip_runtime.h>
#include <hip/hip_cooperative_groups.h>
#include <cstdio>
#include <type_traits>
namespace cg = cooperative_groups;

typedef unsigned short u16;
using bf16x8 = __attribute__((ext_vector_type(8))) short;
using f32x16 = __attribute__((ext_vector_type(16))) float;
using u32x4 = __attribute__((ext_vector_type(4))) unsigned;
#define DI __device__ __forceinline__
#define MFMA(a, b, c) __builtin_amdgcn_mfma_f32_32x32x16_bf16((a), (b), (c), 0, 0, 0)

constexpr int DM = 1024, NBATCH = 16, TPB = 2304, MTOK = 36864, DFF = 2816;
constexpr float ALPHA = 1.681792830507429f;
constexpr float LOG2E = 1.4426950408889634f;
constexpr int SMEM_BYTES = 55296;
#define SELFCHECK 0

struct P {
  const float *x, *c, *ctx, *c_ctx, *w_ada, *b_ada, *w_in, *w_out, *rpb, *qn, *kn, *hlb, *hgn, *ln1g, *ln1b, *w_up,
      *conv_w, *conv_b, *w_down, *ln2g, *ln2b;
  float* out;
  char* ws;
};
constexpr size_t al256(size_t x) { return (x + 255) & ~(size_t)255; }
constexpr size_t O_XC = 0;
constexpr size_t O_WIN = O_XC + al256((size_t)16 * 256 * 1024 * 4);
constexpr size_t O_WOUT = O_WIN + al256((size_t)3072 * 1024 * 2);
constexpr size_t O_WUP = O_WOUT + al256((size_t)1024 * 1024 * 2);
constexpr size_t O_WDN = O_WUP + al256((size_t)5632 * 1024 * 2);
constexpr size_t O_MOD = O_WDN + al256((size_t)1024 * 2816 * 2);
constexpr size_t O_LB = O_MOD + al256((size_t)4 * 17 * 6144 * 4);
constexpr size_t O_ROPE = O_LB + al256(2048 * 4);
constexpr size_t O_DST = O_ROPE + al256(64 * 32 * 4);
constexpr size_t O_H = O_DST + al256((size_t)128 * 36 * 64 * 4);
constexpr size_t O_R = O_H + al256((size_t)36864 * 1024 * 2);
constexpr size_t O_AQ = O_R;
constexpr size_t O_AK = O_AQ + (size_t)36864 * 384 * 2;
constexpr size_t O_AVT = O_AK + (size_t)36864 * 384 * 2;
constexpr size_t O_BQ = O_AVT + (size_t)36864 * 384 * 2;
constexpr size_t O_BKK = O_BQ + (size_t)36864 * 384 * 2;
constexpr size_t O_BVT = O_BKK + (size_t)36864 * 128 * 2;
constexpr size_t O_CI = O_BVT + (size_t)36864 * 128 * 2;
constexpr size_t O_CQ = O_CI + (size_t)36864 * 256 * 2;
constexpr size_t O_CG = O_CQ + (size_t)36864 * 256 * 2;
constexpr size_t O_LOGF = O_CG + (size_t)36864 * 256 * 2;
constexpr size_t O_MIX = O_LOGF + (size_t)36864 * 512 * 4;
constexpr size_t O_STT = O_MIX + (size_t)36864 * 1024 * 2;
constexpr size_t O_END = O_STT + (size_t)128 * 36 * 4096 * 2;
constexpr size_t O_FLAG = O_END;
constexpr size_t O_BAR = O_END + 256;
constexpr size_t O_STATS = O_BAR + 16384;
constexpr size_t O_MISC = O_STATS + (size_t)36864 * 8;
constexpr size_t O_TOTAL = O_MISC + 256;
constexpr size_t O_ACT = O_R;
constexpr size_t O_HALO = O_ACT + (size_t)36864 * 2816 * 2;
constexpr size_t O_PART = O_HALO + (size_t)288 * 4 * 5632 * 4;
#define pXC ((float*)(p.ws + O_XC))
#define pH ((u16*)(p.ws + O_H))
#define pWinT ((u16*)(p.ws + O_WIN))
#define pWoutT ((u16*)(p.ws + O_WOUT))
#define pWupT ((u16*)(p.ws + O_WUP))
#define pWdownT ((u16*)(p.ws + O_WDN))
#define pMOD ((float*)(p.ws + O_MOD))
#define pPART ((float*)(p.ws + O_PART))
#define pLB ((float*)(p.ws + O_LB))
#define pROPE ((float*)(p.ws + O_ROPE))
#define pLOGF ((float*)(p.ws + O_LOGF))
#define pUST ((float*)(p.ws + O_H))
#define pDST ((float*)(p.ws + O_DST))
#define pHALO ((float*)(p.ws + O_HALO))
#define pAQ ((u16*)(p.ws + O_AQ))
#define pAK ((u16*)(p.ws + O_AK))
#define pAVT ((u16*)(p.ws + O_AVT))
#define pBQ ((u16*)(p.ws + O_BQ))
#define pBKK ((u16*)(p.ws + O_BKK))
#define pBVT ((u16*)(p.ws + O_BVT))
#define pCI ((u16*)(p.ws + O_CI))
#define pCQ ((u16*)(p.ws + O_CQ))
#define pCG ((u16*)(p.ws + O_CG))
#define pMIX ((u16*)(p.ws + O_MIX))
#define pSTT ((u16*)(p.ws + O_STT))
#define pACT ((u16*)(p.ws + O_ACT))
#define pSTATS ((float*)(p.ws + O_STATS))
#define pMISC ((float*)(p.ws + O_MISC))

DI int otid() { int t = threadIdx.x; asm volatile("" : "+v"(t)); return t; }
DI int obid() { int t = blockIdx.x; asm volatile("" : "+s"(t)); return t; }
DI int crow(int i, int h) { return (i & 3) + 8 * (i >> 2) + 4 * h; }
typedef __bf16 hbf2 __attribute__((ext_vector_type(2)));
typedef float hf2 __attribute__((ext_vector_type(2)));
DI unsigned pack2(float a, float b) {
  hf2 v = {a, b};
  return __builtin_bit_cast(unsigned, __builtin_convertvector(v, hbf2));
}
DI unsigned f2bf(float x) { return pack2(x, x) & 0xffffu; }
DI float bf2f(u16 v) { return __uint_as_float(((unsigned)v) << 16); }
DI float siluf(float x) { return x * __builtin_amdgcn_rcpf(1.f + __expf(-x)); }
DI float ex2(float x) { return __builtin_amdgcn_exp2f(x); }
DI bf16x8 mk8(unsigned a, unsigned b, unsigned c, unsigned d) {
  u32x4 v = {a, b, c, d};
  return __builtin_bit_cast(bf16x8, v);
}
DI bf16x8 ld8(const void* p) { return *reinterpret_cast<const bf16x8*>(p); }
DI float* xrow(const P& p, int m) {
  int b = m / TPB, i = m - b * TPB;
  return i < 256 ? pXC + ((size_t)(b * 256 + i) << 10) : p.out + ((size_t)(b * 2048 + i - 256) << 10);
}
DI float wave_sum(float v) {
#pragma unroll
  for (int o = 32; o >= 1; o >>= 1) v += __shfl_xor(v, o);
  return v;
}


#define XB_TMO      128
#define XB_XCNT(j)  (256  + 64 * (j))
#define XB_XSUB(j)  (1280 + 64 * (j))
#define XB_XGEN(j)  (2304 + 64 * (j))
#define XB_TOP      3328
#define XB_TOPGEN   3392
#define XCD_BAR_WORDS 3456
#define XB_SPIN_CAP (1u << 22)
#define LAS __attribute__((address_space(3)))
DI unsigned xb_ld(unsigned* p) { return __hip_atomic_load(p, __ATOMIC_RELAXED, __HIP_MEMORY_SCOPE_AGENT); }
DI unsigned xb_add(unsigned* p, unsigned v) { return __hip_atomic_fetch_add(p, v, __ATOMIC_RELAXED, __HIP_MEMORY_SCOPE_AGENT); }
DI unsigned xb_xcc_id() { return (unsigned)__builtin_amdgcn_s_getreg((3 << 11) | 20) & 0xFu; }
#define XB_SPIN(cond, bar) do { unsigned _sp = 0; while (cond) { __builtin_amdgcn_s_sleep(1); \
    if ((++_sp & 255u) == 0u) { if (xb_ld(&(bar)[XB_TMO])) break; if (_sp > XB_SPIN_CAP) { atomicAdd(&(bar)[XB_TMO], 1u); break; } } } } while (0)
struct XcdBarrier { unsigned* bar; unsigned x; volatile LAS unsigned* st; };
DI XcdBarrier xcd_barrier_post(unsigned* bar, volatile LAS unsigned* st) {
  XcdBarrier b; b.bar = bar; b.x = xb_xcc_id(); b.st = st;
  if (threadIdx.x == 0) (void)xb_add(&bar[XB_XCNT(b.x)], 1u);
  return b;
}
DI void xcd_barrier_complete(unsigned* bar, unsigned x, unsigned& nloc, unsigned& nx) {
  const unsigned G = gridDim.x * gridDim.y * gridDim.z;
  unsigned sum, cnt, mine, sp = 0u;
  for (;;) {
    sum = 0u; cnt = 0u; mine = 0u;
#pragma unroll
    for (unsigned j = 0; j < 16; ++j) { const unsigned c = xb_ld(&bar[XB_XCNT(j)]); sum += c; cnt += (c > 0u) ? 1u : 0u; mine = (j == x) ? c : mine; }
    if (sum == G) break;
    __builtin_amdgcn_s_sleep(1);
    if ((++sp & 255u) == 0u) { if (xb_ld(&bar[XB_TMO])) break; if (sp > XB_SPIN_CAP) { atomicAdd(&bar[XB_TMO], 1u); break; } }
  }
  nloc = mine > 0u ? mine : 1u; nx = cnt > 0u ? cnt : 1u;
}
DI void xcd_barrier(const XcdBarrier& b) {
  asm volatile("s_waitcnt vmcnt(0)" ::: "memory");
  __syncthreads();
  if (threadIdx.x == 0) {
    unsigned* bar = b.bar;
    __builtin_amdgcn_s_waitcnt(0);
    unsigned nloc = b.st[0], nx = b.st[1];
    if (nloc == 0u) { xcd_barrier_complete(bar, b.x, nloc, nx); b.st[0] = nloc; b.st[1] = nx; }
    const unsigned old = xb_add(&bar[XB_XSUB(b.x)], 1u);
    const unsigned gen = old / nloc;
    if (old + 1u == (gen + 1u) * nloc) {
      __builtin_amdgcn_fence(__ATOMIC_RELEASE, "agent");
      asm volatile("s_waitcnt vmcnt(0)" ::: "memory");
      const unsigned og = xb_add(&bar[XB_TOP], 1u);
      const unsigned tg = og / nx;
      if (og + 1u == (tg + 1u) * nx) xb_add(&bar[XB_TOPGEN], 1u);
      else XB_SPIN(xb_ld(&bar[XB_TOPGEN]) == tg, bar);
      __builtin_amdgcn_fence(__ATOMIC_ACQUIRE, "agent");
      xb_add(&bar[XB_XGEN(b.x)], 1u);
      asm volatile("s_waitcnt vmcnt(0)" ::: "memory");
    } else {
      XB_SPIN(xb_ld(&bar[XB_XGEN(b.x)]) == gen, bar);
      __builtin_amdgcn_fence(__ATOMIC_ACQUIRE, "agent");
      asm volatile("s_waitcnt vmcnt(0)" ::: "memory");
    }
  }
  __syncthreads();
}

DI void conv_tile(const float* __restrict__ src, int N, u16* __restrict__ dst, int Kd, int k0, int n0, bool perm, char* smem) {
  float* t = (float*)smem;
  const int tid = otid();
#pragma unroll
  for (int i = 0; i < 16; ++i) {
    int idx = tid + 256 * i, kk = idx >> 6, nn = idx & 63;
    t[kk * 65 + nn] = src[(size_t)(k0 + kk) * N + n0 + nn];
  }
  __syncthreads();
#pragma unroll
  for (int i = 0; i < 2; ++i) {
    int cidx = tid + 256 * i, nn = cidx >> 3, kg = cidx & 7;
    float v[8];
#pragma unroll
    for (int j = 0; j < 8; ++j) v[j] = t[(kg * 8 + j) * 65 + nn];
    int n = n0 + nn;
    if (perm) {
      int tn = n / DFF, jj = n - tn * DFF;
      n = (jj >> 6) * 128 + ((jj >> 5) & 1) * 64 + tn * 32 + (jj & 31);
    }
    u32x4 o = {pack2(v[0], v[1]), pack2(v[2], v[3]), pack2(v[4], v[5]), pack2(v[6], v[7])};
    *reinterpret_cast<u32x4*>(dst + (size_t)n * Kd + k0 + kg * 8) = o;
  }
  __syncthreads();
}
DI void convert_weights(const P& p, int l, int which, char* smem) {
  int n_in = (which & 1) ? 16 * 48 : 0, n_out = (which & 2) ? 16 * 16 : 0, n_up = (which & 4) ? 16 * 88 : 0,
      n_dn = (which & 8) ? 44 * 16 : 0;
  int total = n_in + n_out + n_up + n_dn;
  for (int it = obid(); it < total; it += gridDim.x) {
    int i = it;
    if (i < n_in) { conv_tile(p.w_in + (size_t)l * 1024 * 3072, 3072, pWinT, 1024, (i / 48) * 64, (i % 48) * 64, false, smem); continue; }
    i -= n_in;
    if (i < n_out) { conv_tile(p.w_out + (size_t)l * 1024 * 1024, 1024, pWoutT, 1024, (i / 16) * 64, (i % 16) * 64, false, smem); continue; }
    i -= n_out;
    if (i < n_up) { conv_tile(p.w_up + (size_t)l * 1024 * 5632, 5632, pWupT, 1024, (i / 88) * 64, (i % 88) * 64, true, smem); continue; }
    i -= n_up;
    conv_tile(p.w_down + (size_t)l * DFF * 1024, 1024, pWdownT, DFF, (i / 16) * 64, (i % 16) * 64, false, smem);
  }
}

template <int TM, bool SWAP = false>
DI void gemm_main(const u16* __restrict__ Wt, const u16* __restrict__ A, int K, int n0, int m0, int rot, char* smem, f32x16 (&acc)[2][TM]) {
  const int tid = otid(), lane = tid & 63, w = tid >> 6, wn = w & 1, wm = w >> 1, r = lane & 31, h = lane >> 5;
  const int srow = tid >> 3, skc = tid & 7;
  const u16* gW = Wt + (size_t)(n0 + srow) * K + skc * 8;
  const u16* gA = A + (size_t)(m0 + srow) * K + skc * 8;
  const int T = K >> 6;
  int kt = rot % T;
  u32x4 rw[4], ra[2 * TM];
#pragma unroll
  for (int i = 0; i < 4; ++i) rw[i] = *reinterpret_cast<const u32x4*>(gW + (size_t)i * 32 * K + kt * 64);
#pragma unroll
  for (int i = 0; i < 2 * TM; ++i) ra[i] = *reinterpret_cast<const u32x4*>(gA + (size_t)i * 32 * K + kt * 64);
#pragma unroll
  for (int a = 0; a < 2; ++a)
#pragma unroll
    for (int b = 0; b < TM; ++b)
#pragma unroll
      for (int i = 0; i < 16; ++i) acc[a][b][i] = 0.f;
  char* sW = smem + (srow * 144 + skc * 16);
  char* sA = smem + ((128 + srow) * 144 + skc * 16);
  const char* fW = smem + ((wn * 64 + r) * 144 + h * 16);
  const char* fA = smem + ((128 + wm * (TM * 32) + r) * 144 + h * 16);
  for (int t = 0; t < T; ++t) {
    __syncthreads();
#pragma unroll
    for (int i = 0; i < 4; ++i) *reinterpret_cast<u32x4*>(sW + i * 32 * 144) = rw[i];
#pragma unroll
    for (int i = 0; i < 2 * TM; ++i) *reinterpret_cast<u32x4*>(sA + i * 32 * 144) = ra[i];
    __syncthreads();
    if (t + 1 < T) {
      kt = (kt + 1 == T) ? 0 : kt + 1;
#pragma unroll
      for (int i = 0; i < 4; ++i) rw[i] = *reinterpret_cast<const u32x4*>(gW + (size_t)i * 32 * K + kt * 64);
#pragma unroll
      for (int i = 0; i < 2 * TM; ++i) ra[i] = *reinterpret_cast<const u32x4*>(gA + (size_t)i * 32 * K + kt * 64);
    }
    {
      bf16x8 fa[2][2], fb[TM];
      fa[0][0] = ld8(fW); fa[0][1] = ld8(fW + 32 * 144);
#pragma unroll
      for (int tm = 0; tm < TM; ++tm) fb[tm] = ld8(fA + tm * 32 * 144);
#pragma unroll
      for (int s = 0; s < 4; ++s) {
        const int cb = s & 1, nb = cb ^ 1;
        if (s < 3) { fa[nb][0] = ld8(fW + (s + 1) * 32); fa[nb][1] = ld8(fW + 32 * 144 + (s + 1) * 32); }
#pragma unroll
        for (int tm = 0; tm < TM; ++tm) {
          if (SWAP) {
            acc[0][tm] = MFMA(fb[tm], fa[cb][0], acc[0][tm]);
            acc[1][tm] = MFMA(fb[tm], fa[cb][1], acc[1][tm]);
          } else {
            acc[0][tm] = MFMA(fa[cb][0], fb[tm], acc[0][tm]);
            acc[1][tm] = MFMA(fa[cb][1], fb[tm], acc[1][tm]);
          }
          if (s < 3) fb[tm] = ld8(fA + tm * 32 * 144 + (s + 1) * 32);
        }
        if (s < 3) {
          __builtin_amdgcn_sched_group_barrier(0x100, 2, 0);
#pragma unroll
          for (int q = 0; q < TM; ++q) {
            __builtin_amdgcn_sched_group_barrier(0x008, 2, 0);
            __builtin_amdgcn_sched_group_barrier(0x100, 1, 0);
          }
        }
      }
    }
  }
}

DI bool gemm_tile_of(int j, int NT, int MG, int& mt, int& nt) {
  const int xcd = obid() & 7;
  const int per = MG * NT;
  const int g = j / per, rem = j - g * per;
  nt = rem / MG;
  mt = (g * MG + (rem - nt * MG)) * 8 + xcd;
  return true;
}
DI void store_rm(u16* __restrict__ dst, int ld, int col0, int mw0, f32x16 (&acc)[2][4], float scale, int r, int h) {
#pragma unroll
  for (int tn = 0; tn < 2; ++tn)
#pragma unroll
    for (int tm = 0; tm < 4; ++tm) {
      size_t m = mw0 + tm * 32 + r;
#pragma unroll
      for (int g = 0; g < 4; ++g) {
        uint2 v;
        v.x = pack2(acc[tn][tm][4 * g] * scale, acc[tn][tm][4 * g + 1] * scale);
        v.y = pack2(acc[tn][tm][4 * g + 2] * scale, acc[tn][tm][4 * g + 3] * scale);
        *reinterpret_cast<uint2*>(dst + m * ld + col0 + tn * 32 + 8 * g + 4 * h) = v;
      }
      asm volatile("" ::: "memory");
    }
}
DI void store_tr(u16* __restrict__ dst, int tok0, f32x16 (&acc)[2][4], int r, int h) {
#pragma unroll
  for (int tn = 0; tn < 2; ++tn)
#pragma unroll
    for (int tm = 0; tm < 4; ++tm) {
      u16* bp = dst + (size_t)(tn * 32 + 4 * h) * TPB + tok0 + tm * 32 + r;
#pragma unroll
      for (int i = 0; i < 16; i += 2) {
        unsigned pk = pack2(acc[tn][tm][i], acc[tn][tm][i + 1]);
        bp[(size_t)((i & 3) + 8 * (i >> 2)) * TPB] = (u16)(pk & 0xffffu);
        bp[(size_t)(((i + 1) & 3) + 8 * ((i + 1) >> 2)) * TPB] = (u16)(pk >> 16);
      }
      asm volatile("" ::: "memory");
    }
}
DI void norm_rope_store(const P& p, const f32x16 (&acc)[2][4], const float* __restrict__ gw, bool isctx, int tokw0,
                        u16* __restrict__ dst, int ld, int col0, int mw0, float scale, int r, int h) {
#pragma unroll
  for (int tm = 0; tm < 4; ++tm) {
    float ss = 0.f;
#pragma unroll
    for (int tn = 0; tn < 2; ++tn)
#pragma unroll
      for (int i = 0; i < 16; ++i) ss += acc[tn][tm][i] * acc[tn][tm][i];
    ss += __shfl_xor(ss, 32);
    const float rs = rsqrtf(ss * (1.f / 64.f) + 1e-6f) * scale;
    const int tok = tokw0 + tm * 32 + r - 256;
    u16* drow = dst + (size_t)(mw0 + tm * 32 + r) * ld + col0 + 4 * h;
#pragma unroll
    for (int tn = 0; tn < 2; ++tn) {
      const int pos = isctx ? 0 : (tn == 0 ? (tok >> 6) : (tok & 63));
      const float* rp = pROPE + pos * 32 + 4 * h;
      const float* gp = gw + tn * 32 + 4 * h;
#pragma unroll
      for (int g = 0; g < 2; ++g) {
        const float4 c4 = *reinterpret_cast<const float4*>(rp + 8 * g);
        const float4 s4 = *reinterpret_cast<const float4*>(rp + 16 + 8 * g);
        const float4 ga = *reinterpret_cast<const float4*>(gp + 8 * g);
        const float4 gb = *reinterpret_cast<const float4*>(gp + 16 + 8 * g);
        const float cs[4] = {c4.x, c4.y, c4.z, c4.w}, sn[4] = {s4.x, s4.y, s4.z, s4.w};
        const float g1[4] = {ga.x, ga.y, ga.z, ga.w}, g2[4] = {gb.x, gb.y, gb.z, gb.w};
        float y1[4], y2[4];
#pragma unroll
        for (int j = 0; j < 4; ++j) {
          const int i = 4 * g + j;
          float x1 = acc[tn][tm][i] * rs * g1[j], x2 = acc[tn][tm][i + 8] * rs * g2[j];
          float c = isctx ? 1.f : cs[j], s = isctx ? 0.f : sn[j];
          y1[j] = x1 * c - x2 * s;
          y2[j] = x2 * c + x1 * s;
        }
        uint2 v1, v2;
        v1.x = pack2(y1[0], y1[1]); v1.y = pack2(y1[2], y1[3]);
        v2.x = pack2(y2[0], y2[1]); v2.y = pack2(y2[2], y2[3]);
        *reinterpret_cast<uint2*>(drow + tn * 32 + 8 * g) = v1;
        *reinterpret_cast<uint2*>(drow + tn * 32 + 8 * g + 16) = v2;
      }
    }
    asm volatile("" ::: "memory");
  }
}

DI void proj_phase(const P& p, int l, char* smem) {
  const int ntiles = 18 * 24;
  for (int it = obid() >> 3; it < ntiles; it += (gridDim.x >> 3)) {
    int nt, mt;
    gemm_tile_of(it, 24, 6, mt, nt);
    int n0 = nt * 128, m0 = mt * 256;
    bool isctx = (mt % 9) == 0;
    if (l == 3 && isctx && n0 >= 1792) continue;
    f32x16 acc[2][4];
    gemm_main<4>(pWinT, pH, 1024, n0, m0, mt * 3, smem, acc);
    const int tid = otid(), lane = tid & 63, w = tid >> 6, wn = w & 1, wm = w >> 1, r = lane & 31, h = lane >> 5;
    int nw = n0 + wn * 64;
    int mw0 = m0 + wm * 128;
    int b = m0 / TPB, tokw0 = mw0 - b * TPB;
    if (nw < 384) store_rm(pAK, 384, nw, mw0, acc, 1.f, r, h);
    else if (nw < 768) store_tr(pAVT + (size_t)(b * 6 + (nw - 384) / 64) * 64 * TPB, tokw0, acc, r, h);
    else if (nw < 896) norm_rope_store(p, acc, p.kn + l * 64, isctx, tokw0, pBKK, 128, nw - 768, mw0, 1.f, r, h);
    else if (nw < 1024) store_tr(pBVT + (size_t)(b * 2 + (nw - 896) / 64) * 64 * TPB, tokw0, acc, r, h);
    else if (nw < 1536) {
      const float* lbp = pLB + l * 512 + (nw - 1024);
#pragma unroll
      for (int tn = 0; tn < 2; ++tn)
#pragma unroll
        for (int tm = 0; tm < 4; ++tm) {
          size_t m = mw0 + tm * 32 + r;
#pragma unroll
          for (int g = 0; g < 4; ++g) {
            int cl = tn * 32 + 8 * g + 4 * h;
            float4 o;
            float* op = &o.x;
#pragma unroll
            for (int j = 0; j < 4; ++j) {
              float lb = lbp[cl + j], z = acc[tn][tm][4 * g + j];
              float sg = __builtin_amdgcn_rcpf(1.f + __expf(-z));
              op[j] = __logf(fmaxf(lb, 1e-30f) + (1.f - lb) * sg);
            }
            *reinterpret_cast<float4*>(pLOGF + m * 512 + (nw - 1024) + cl) = o;
          }
          asm volatile("" ::: "memory");
        }
    } else if (nw < 1792) store_rm(pCI, 256, nw - 1536, mw0, acc, 1.f, r, h);
    else if (nw < 2176) store_rm(pAQ, 384, nw - 1792, mw0, acc, 0.125f * LOG2E, r, h);
    else if (nw < 2560) norm_rope_store(p, acc, p.qn + l * 64, isctx, tokw0, pBQ, 384, nw - 2176, mw0, 0.125f * LOG2E, r, h);
    else if (nw < 2816) store_rm(pCQ, 256, nw - 2560, mw0, acc, 0.125f, r, h);
    else store_rm(pCG, 256, nw - 2816, mw0, acc, 1.f, r, h);
  }
}

DI void res_gemm_phase(const P& p, int l, const u16* Wt, const u16* A, int K, int gidx, char* smem) {
  const int ntiles = 24 * 8;
  for (int it = obid() >> 3; it < ntiles; it += (gridDim.x >> 3)) {
    int nt, mt;
    gemm_tile_of(it, 8, 1, mt, nt);
    int n0 = nt * 128, m0 = mt * 192;
    if (l == 3 && (m0 % TPB) == 0) continue;
    f32x16 acc[2][3];
    gemm_main<3>(Wt, A, K, n0, m0, mt * 3, smem, acc);
    const int tid = otid(), lane = tid & 63, w = tid >> 6, wn = w & 1, wm = w >> 1, r = lane & 31, h = lane >> 5;
    const bool ident = (gidx == 2 && l == 0);
    const float* lg = gidx == 2 ? p.ln2g + (l - 1) * 1024 : p.ln1g + l * 1024;
    const float* lb = gidx == 2 ? p.ln2b + (l - 1) * 1024 : p.ln1b + l * 1024;
#pragma unroll
    for (int tn = 0; tn < 2; ++tn)
#pragma unroll
      for (int tm = 0; tm < 3; ++tm) {
        const int m = m0 + wm * 96 + tm * 32 + r;
        const int b = m / TPB;
        const bool isctx = (m - b * TPB) < 256;
        const float* gp = pMOD + ((size_t)(l * 17 + (isctx ? 16 : b)) * 6 + gidx) * 1024;
        float* xr = xrow(p, m);
        const float2 st = *reinterpret_cast<const float2*>(pSTATS + 2 * (size_t)m);
#pragma unroll
        for (int g = 0; g < 4; ++g) {
          int n = n0 + wn * 64 + tn * 32 + 8 * g + 4 * h;
          float4 xv = *reinterpret_cast<float4*>(xr + n);
          if (!ident) {
            float4 G4 = *reinterpret_cast<const float4*>(lg + n);
            float4 B4 = *reinterpret_cast<const float4*>(lb + n);
            xv.x = (xv.x - st.x) * st.y * G4.x + B4.x;
            xv.y = (xv.y - st.x) * st.y * G4.y + B4.y;
            xv.z = (xv.z - st.x) * st.y * G4.z + B4.z;
            xv.w = (xv.w - st.x) * st.y * G4.w + B4.w;
          }
          float4 gv = *reinterpret_cast<const float4*>(gp + n);
          xv.x = ALPHA * xv.x + gv.x * acc[tn][tm][4 * g];
          xv.y = ALPHA * xv.y + gv.y * acc[tn][tm][4 * g + 1];
          xv.z = ALPHA * xv.z + gv.z * acc[tn][tm][4 * g + 2];
          xv.w = ALPHA * xv.w + gv.w * acc[tn][tm][4 * g + 3];
          *reinterpret_cast<float4*>(xr + n) = xv;
        }
      }
  }
}

DI void up_phase(const P& p, int l, char* smem) {
  const int ntiles = 18 * 44;
  float* ut = (float*)smem;
  const int loc_up = obid() >> 3;
  const bool first_conv = (((loc_up >> 5) ^ loc_up) & 1) != 0;
  if (l < 3 && first_conv) convert_weights(p, l + 1, 3, smem);
  for (int it = obid() >> 3; it < ntiles; it += (gridDim.x >> 3)) {
    int nt, mt;
    gemm_tile_of(it, 44, 6, mt, nt);
    int n0 = nt * 128, m0 = mt * 256;
    bool isctx = (mt % 9) == 0;
    if (l == 3 && isctx) continue;
    f32x16 acc[2][4];
    gemm_main<4, true>(pWupT, pH, 1024, n0, m0, mt * 3, smem, acc);
    const int tid = otid(), lane = tid & 63, w = tid >> 6, wn = w & 1, wm = w >> 1, r = lane & 31, h = lane >> 5;
    const float* cw = p.conv_w + (size_t)l * 3 * 5632;
    const float* cb = p.conv_b + (size_t)l * 5632;
    const int j = nt * 64 + wn * 32 + r;
    const float g0 = cw[j], g1 = cw[5632 + j], g2 = cw[2 * 5632 + j], gb = cb[j];
    const float v0 = cw[DFF + j], v1 = cw[5632 + DFF + j], v2 = cw[2 * 5632 + DFF + j], vb = cb[DFF + j];
    const int mt2 = mt * 2 + wm, mb = m0 + wm * 128;
    u16* arow = pACT + (size_t)mb * DFF + j;
    float* hrow = pHALO + (size_t)mt2 * 4 * 5632 + j;
    float P3g[4][4], P0g[4][4], P3v[4][4], P0v[4][4];
#pragma unroll
    for (int tm = 0; tm < 4; ++tm)
#pragma unroll
      for (int g = 0; g < 4; ++g) {
        P3g[tm][g] = __shfl_xor(acc[0][tm][4 * g + 3], 32); P0g[tm][g] = __shfl_xor(acc[0][tm][4 * g], 32);
        P3v[tm][g] = __shfl_xor(acc[1][tm][4 * g + 3], 32); P0v[tm][g] = __shfl_xor(acc[1][tm][4 * g], 32);
      }
#pragma unroll
    for (int tm = 0; tm < 4; ++tm)
#pragma unroll
      for (int g = 0; g < 4; ++g) {
        const float lo_g = (g > 0) ? P3g[tm][g > 0 ? g - 1 : 0] : (tm > 0 ? P3g[tm > 0 ? tm - 1 : 0][3] : 0.f);
        const float lo_v = (g > 0) ? P3v[tm][g > 0 ? g - 1 : 0] : (tm > 0 ? P3v[tm > 0 ? tm - 1 : 0][3] : 0.f);
        const float pgE = h ? P3g[tm][g] : lo_g, pvE = h ? P3v[tm][g] : lo_v;
        const float hi_g = (g < 3) ? P0g[tm][g < 3 ? g + 1 : 3] : (tm < 3 ? P0g[tm < 3 ? tm + 1 : 3][0] : 0.f);
        const float hi_v = (g < 3) ? P0v[tm][g < 3 ? g + 1 : 3] : (tm < 3 ? P0v[tm < 3 ? tm + 1 : 3][0] : 0.f);
        const float ngE = h ? hi_g : P0g[tm][g], nvE = h ? hi_v : P0v[tm][g];
#pragma unroll
        for (int k = 0; k < 4; ++k) {
          const int i = 4 * g + k;
          const float pg = k > 0 ? acc[0][tm][k > 0 ? i - 1 : i] : pgE, ng = k < 3 ? acc[0][tm][k < 3 ? i + 1 : i] : ngE;
          const float pv = k > 0 ? acc[1][tm][k > 0 ? i - 1 : i] : pvE, nv = k < 3 ? acc[1][tm][k < 3 ? i + 1 : i] : nvE;
          const float gate = g0 * pg + g1 * acc[0][tm][i] + g2 * ng + gb;
          const float val = v0 * pv + v1 * acc[1][tm][i] + v2 * nv + vb;
          const int t = tm * 32 + 8 * g + 4 * h + k;
          if (!((tm == 0 && g == 0 && k == 0 && h == 0) || (tm == 3 && g == 3 && k == 3 && h == 1)))
            arow[(size_t)t * DFF] = (u16)f2bf(siluf(gate) * val);
        }
      }
    if (h == 0) {
      hrow[0] = acc[0][0][0]; hrow[DFF] = acc[1][0][0];
      hrow[5632] = acc[0][0][1]; hrow[5632 + DFF] = acc[1][0][1];
    } else {
      hrow[2 * 5632] = acc[0][3][14]; hrow[2 * 5632 + DFF] = acc[1][3][14];
      hrow[3 * 5632] = acc[0][3][15]; hrow[3 * 5632 + DFF] = acc[1][3][15];
    }
  }
  __syncthreads();
  if (l < 3 && !first_conv) convert_weights(p, l + 1, 3, smem);
}

DI void fixup_phase(const P& p, int l) {
  const int total = 288 * DFF;
  const float* cw = p.conv_w + (size_t)l * 3 * 5632;
  const float* cb = p.conv_b + (size_t)l * 5632;
  for (int idx = obid() * 256 + otid(); idx < total; idx += gridDim.x * 256) {
    int mt = idx / DFF, j = idx - mt * DFF;
    int tb = mt % 18;
    bool isctx = tb < 2;
    if (l == 3 && isctx) continue;
    bool segstart = (tb == 0) || (tb == 2), segend = (tb == 1) || (tb == 17);
    const float* hm = pHALO + (size_t)mt * 4 * 5632;
    float g0 = cw[j], g1 = cw[5632 + j], g2 = cw[2 * 5632 + j], gb = cb[j];
    float v0 = cw[DFF + j], v1 = cw[5632 + DFF + j], v2 = cw[2 * 5632 + DFF + j], vb = cb[DFF + j];
    {
      float pg = segstart ? 0.f : hm[-5632 + j], pv = segstart ? 0.f : hm[-5632 + DFF + j];
      float gate = g0 * pg + g1 * hm[j] + g2 * hm[5632 + j] + gb;
      float val = v0 * pv + v1 * hm[DFF + j] + v2 * hm[5632 + DFF + j] + vb;
      pACT[(size_t)(mt * 128) * DFF + j] = (u16)f2bf(siluf(gate) * val);
    }
    {
      float ng = segend ? 0.f : hm[4 * 5632 + j], nv = segend ? 0.f : hm[4 * 5632 + DFF + j];
      float gate = g0 * hm[2 * 5632 + j] + g1 * hm[3 * 5632 + j] + g2 * ng + gb;
      float val = v0 * hm[2 * 5632 + DFF + j] + v1 * hm[3 * 5632 + DFF + j] + v2 * nv + vb;
      pACT[(size_t)(mt * 128 + 127) * DFF + j] = (u16)f2bf(siluf(gate) * val);
    }
  }
}

DI void ln_phase(const P& p, int mode, int l) {
  const int lane = otid() & 63;
  const int gw = obid() * 4 + (otid() >> 6), nw = gridDim.x * 4;
  const bool latonly = (mode != 0 && l == 3);
  const int nrows = latonly ? 16 * 2048 : MTOK;
  const bool final_ = (mode == 2 && l == 3);
  auto row_of = [&](int idx) { return latonly ? (idx >> 11) * TPB + 256 + (idx & 2047) : idx; };
  auto src_of = [&](int row) -> const float* {
    int b = row / TPB, i = row - b * TPB;
    if (mode == 0) return i < 256 ? p.ctx + ((size_t)(b * 256 + i) << 10) : p.x + ((size_t)(b * 2048 + i - 256) << 10);
    return xrow(p, row);
  };
  float4 nx[4];
  if (gw < nrows) {
    const float* s0 = src_of(row_of(gw));
#pragma unroll
    for (int q = 0; q < 4; ++q) nx[q] = *reinterpret_cast<const float4*>(s0 + q * 256 + lane * 4);
  }
  for (int idx = gw; idx < nrows; idx += nw) {
    const int row = row_of(idx);
    const int b = row / TPB, i = row - b * TPB;
    const bool isctx = i < 256;
    float v[16];
#pragma unroll
    for (int q = 0; q < 4; ++q) { v[4 * q] = nx[q].x; v[4 * q + 1] = nx[q].y; v[4 * q + 2] = nx[q].z; v[4 * q + 3] = nx[q].w; }
    if (idx + nw < nrows) {
      const float* s1 = src_of(row_of(idx + nw));
#pragma unroll
      for (int q = 0; q < 4; ++q) nx[q] = *reinterpret_cast<const float4*>(s1 + q * 256 + lane * 4);
    }
    if (mode != 0) {
      float s = 0.f;
#pragma unroll
      for (int q = 0; q < 16; ++q) s += v[q];
      float mu = wave_sum(s) * (1.f / 1024.f);
      float s2 = 0.f;
#pragma unroll
      for (int q = 0; q < 16; ++q) { v[q] -= mu; s2 += v[q] * v[q]; }
      float rs = rsqrtf(wave_sum(s2) * (1.f / 1024.f) + 1e-6f);
      if (!final_ && lane == 0) { float2 st = {mu, rs}; *reinterpret_cast<float2*>(pSTATS + 2 * (size_t)row) = st; }
      const float* gg = (mode == 1 ? p.ln1g : p.ln2g) + l * 1024;
      const float* bb = (mode == 1 ? p.ln1b : p.ln2b) + l * 1024;
#pragma unroll
      for (int q = 0; q < 4; ++q) {
        float4 g4 = *reinterpret_cast<const float4*>(gg + q * 256 + lane * 4);
        float4 b4 = *reinterpret_cast<const float4*>(bb + q * 256 + lane * 4);
        v[4 * q] = v[4 * q] * rs * g4.x + b4.x;
        v[4 * q + 1] = v[4 * q + 1] * rs * g4.y + b4.y;
        v[4 * q + 2] = v[4 * q + 2] * rs * g4.z + b4.z;
        v[4 * q + 3] = v[4 * q + 3] * rs * g4.w + b4.w;
      }
    } else if (lane == 0) {
      float2 st = {0.f, 1.f};
      *reinterpret_cast<float2*>(pSTATS + 2 * (size_t)row) = st;
    }
    if (mode == 0 || final_) {
      float* dst = xrow(p, row);
#if SELFCHECK
      if (final_) {
        float bump = (float)(*((volatile unsigned*)(p.ws + O_FLAG)));
#pragma unroll
        for (int q = 0; q < 16; ++q) v[q] += bump;
      }
#endif
#pragma unroll
      for (int q = 0; q < 4; ++q) {
        float4 t = {v[4 * q], v[4 * q + 1], v[4 * q + 2], v[4 * q + 3]};
        *reinterpret_cast<float4*>(dst + q * 256 + lane * 4) = t;
      }
    }
    if (final_) continue;
    {
      float s = 0.f;
#pragma unroll
      for (int q = 0; q < 16; ++q) s += v[q];
      float mu = wave_sum(s) * (1.f / 1024.f);
      float s2 = 0.f;
#pragma unroll
      for (int q = 0; q < 16; ++q) { v[q] -= mu; s2 += v[q] * v[q]; }
      float rs = rsqrtf(wave_sum(s2) * (1.f / 1024.f) + 1e-6f);
      int ml = mode == 2 ? l + 1 : (mode == 0 ? 0 : l);
      int sidx = mode == 1 ? 3 : 0;
      const float* sh = pMOD + ((size_t)(ml * 17 + (isctx ? 16 : b)) * 6 + sidx) * 1024;
      const float* sc = sh + 1024;
#pragma unroll
      for (int q = 0; q < 4; ++q) {
        float4 s4 = *reinterpret_cast<const float4*>(sh + q * 256 + lane * 4);
        float4 c4 = *reinterpret_cast<const float4*>(sc + q * 256 + lane * 4);
        uint2 o;
        o.x = pack2(v[4 * q] * rs * (1.f + c4.x) + s4.x, v[4 * q + 1] * rs * (1.f + c4.y) + s4.y);
        o.y = pack2(v[4 * q + 2] * rs * (1.f + c4.z) + s4.z, v[4 * q + 3] * rs * (1.f + c4.w) + s4.w);
        *reinterpret_cast<uint2*>(pH + (size_t)row * 1024 + q * 256 + lane * 4) = o;
      }
    }
  }
}

template <bool FIXM>
DI void attn_block(const u16* __restrict__ Qp, int ldq, const u16* __restrict__ Kp, int ldk, const u16* __restrict__ Vt, int NT,
                   bool na, int rs_min, int rstart_w, int qr, int q0, const float* __restrict__ rpbh, u16* __restrict__ Op,
                   char* smem, float sshift = 0.f) {
  const int tid = otid(), lane = tid & 63, r = lane & 31, h = lane >> 5;
  bf16x8 qf[4];
#pragma unroll
  for (int s = 0; s < 4; ++s) qf[s] = ld8(Qp + (size_t)r * ldq + 16 * s + 8 * h);
  f32x16 o0, o1;
#pragma unroll
  for (int i = 0; i < 16; ++i) { o0[i] = 0.f; o1[i] = 0.f; }
  float mrun = -1e30f, lrun = 0.f;
  f32x16 lacc;
#pragma unroll
  for (int i = 0; i < 16; ++i) lacc[i] = 0.f;
  const bf16x8 ones8 = mk8(0x3F803F80u, 0x3F803F80u, 0x3F803F80u, 0x3F803F80u);
  const int lrow = tid >> 3, lkc = tid & 7;
  u32x4 rk[2], rv[2];
  char* sst = smem + lrow * 144 + lkc * 16;
#define ATT_KTOK(t) (na ? ((t) < 4 ? 64 * (t) : 256 + (rs_min + (t) - 4) * 64) : 64 * (t))
#define ATT_LOAD(t) do { const int kt_ = ATT_KTOK(t); \
    rk[0] = *reinterpret_cast<const u32x4*>(Kp + (size_t)(kt_ + lrow) * ldk + lkc * 8); \
    rk[1] = *reinterpret_cast<const u32x4*>(Kp + (size_t)(kt_ + lrow + 32) * ldk + lkc * 8); \
    rv[0] = *reinterpret_cast<const u32x4*>(Vt + (size_t)lrow * TPB + kt_ + lkc * 8); \
    rv[1] = *reinterpret_cast<const u32x4*>(Vt + (size_t)(lrow + 32) * TPB + kt_ + lkc * 8); } while (0)
#define ATT_STORE(bf) do { char* d_ = sst + (bf) * 18432; \
    *reinterpret_cast<u32x4*>(d_) = rk[0]; *reinterpret_cast<u32x4*>(d_ + 32 * 144) = rk[1]; \
    *reinterpret_cast<u32x4*>(d_ + 9216) = rv[0]; *reinterpret_cast<u32x4*>(d_ + 9216 + 32 * 144) = rv[1]; } while (0)
  __syncthreads();
  float* lrpb = (float*)(smem + 36864);
  if (na) {
    for (int idx = tid; idx < 465; idx += 256) lrpb[idx] = rpbh[idx];
  }
  ATT_LOAD(0);
  ATT_STORE(0);
  __syncthreads();
  for (int t = 0; t < NT; ++t) {
    if (t + 1 < NT) ATT_LOAD(t + 1);
    const int kr = rs_min + t - 4;
    const bool rowtile = na && t >= 4;
    const bool active = !rowtile || (kr >= rstart_w && kr < rstart_w + 8);
    if (active) {
      const char* kb = smem + (t & 1) * 18432 + r * 144 + h * 16;
      const char* vb = smem + (t & 1) * 18432 + 9216 + r * 144 + h * 8;
      f32x16 S0, S1;
      const float sinit = FIXM ? -sshift : 0.f;
#pragma unroll
      for (int i = 0; i < 16; ++i) { S0[i] = sinit; S1[i] = sinit; }
      {
        bf16x8 kf[8];
#pragma unroll
        for (int s = 0; s < 4; ++s) { kf[s] = ld8(kb + s * 32); kf[4 + s] = ld8(kb + 32 * 144 + s * 32); }
#pragma unroll
        for (int s = 0; s < 4; ++s) S0 = MFMA(kf[s], qf[s], S0);
#pragma unroll
        for (int s = 0; s < 4; ++s) S1 = MFMA(kf[4 + s], qf[s], S1);
      }
      bf16x8 vf[8];
#pragma unroll
      for (int kq = 0; kq < 4; ++kq) {
        uint2 a0 = *reinterpret_cast<const uint2*>(vb + kq * 32), a1 = *reinterpret_cast<const uint2*>(vb + kq * 32 + 16);
        uint2 b0 = *reinterpret_cast<const uint2*>(vb + 32 * 144 + kq * 32), b1 = *reinterpret_cast<const uint2*>(vb + 32 * 144 + kq * 32 + 16);
        vf[kq] = mk8(a0.x, a0.y, a1.x, a1.y);
        vf[4 + kq] = mk8(b0.x, b0.y, b1.x, b1.y);
      }
      if (FIXM) {
#pragma unroll
        for (int i = 0; i < 16; ++i) S0[i] = ex2(S0[i]);
        bf16x8 pa0 = mk8(pack2(S0[0], S0[1]), pack2(S0[2], S0[3]), pack2(S0[4], S0[5]), pack2(S0[6], S0[7]));
        bf16x8 pa1 = mk8(pack2(S0[8], S0[9]), pack2(S0[10], S0[11]), pack2(S0[12], S0[13]), pack2(S0[14], S0[15]));
        o0 = MFMA(vf[0], pa0, o0);
        o1 = MFMA(vf[4], pa0, o1);
        lacc = MFMA(ones8, pa0, lacc);
        o0 = MFMA(vf[1], pa1, o0);
        o1 = MFMA(vf[5], pa1, o1);
        lacc = MFMA(ones8, pa1, lacc);
        __builtin_amdgcn_sched_barrier(0);
#pragma unroll
        for (int i = 0; i < 16; ++i) S1[i] = ex2(S1[i]);
        bf16x8 pa2 = mk8(pack2(S1[0], S1[1]), pack2(S1[2], S1[3]), pack2(S1[4], S1[5]), pack2(S1[6], S1[7]));
        bf16x8 pa3 = mk8(pack2(S1[8], S1[9]), pack2(S1[10], S1[11]), pack2(S1[12], S1[13]), pack2(S1[14], S1[15]));
        o0 = MFMA(vf[2], pa2, o0);
        o1 = MFMA(vf[6], pa2, o1);
        lacc = MFMA(ones8, pa2, lacc);
        o0 = MFMA(vf[3], pa3, o0);
        o1 = MFMA(vf[7], pa3, o1);
        lacc = MFMA(ones8, pa3, lacc);
      } else {
        auto softmax_pv = [&](auto mode_tag) {
          constexpr int MODE = decltype(mode_tag)::value;
          if (MODE != 0) {
            const int wq = q0 + r;
            const int cs = min(max(wq - 8, 0), 48);
            const float* bp = lrpb + (kr - qr + 7) * 31 + 15 - wq;
#pragma unroll
            for (int i = 0; i < 16; ++i) {
              const int kc = crow(i, h);
              if (!(MODE == 2 && i < 12)) {
                bool ok = (kc >= cs) && (kc < cs + 16);
                float bias = bp[ok ? kc : cs] * LOG2E;
                S0[i] = ok ? S0[i] + bias : -1e30f;
              }
              if (!(MODE == 1 && i >= 4)) {
                const int kc2 = kc + 32;
                bool ok2 = (kc2 >= cs) && (kc2 < cs + 16);
                float bias2 = bp[ok2 ? kc2 : cs] * LOG2E;
                S1[i] = ok2 ? S1[i] + bias2 : -1e30f;
              }
            }
          }
          float tmax = -1e30f;
#pragma unroll
          for (int i = 0; i < 16; ++i) {
            if (!(MODE == 2 && i < 12)) tmax = fmaxf(tmax, S0[i]);
            if (!(MODE == 1 && i >= 4)) tmax = fmaxf(tmax, S1[i]);
          }
          tmax = fmaxf(tmax, __shfl_xor(tmax, 32));
          const float mnew = fmaxf(mrun, tmax);
          const float alpha = ex2(mrun - mnew);
          mrun = mnew;
          float ps = 0.f;
#pragma unroll
          for (int i = 0; i < 16; ++i) {
            if (!(MODE == 2 && i < 12)) { S0[i] = ex2(S0[i] - mnew); ps += S0[i]; } else S0[i] = 0.f;
            if (!(MODE == 1 && i >= 4)) { S1[i] = ex2(S1[i] - mnew); ps += S1[i]; } else S1[i] = 0.f;
          }
          lrun = lrun * alpha + ps;
#pragma unroll
          for (int i = 0; i < 16; ++i) { o0[i] *= alpha; o1[i] *= alpha; }
          bf16x8 pb[4];
          pb[0] = mk8(pack2(S0[0], S0[1]), pack2(S0[2], S0[3]), pack2(S0[4], S0[5]), pack2(S0[6], S0[7]));
          pb[1] = mk8(pack2(S0[8], S0[9]), pack2(S0[10], S0[11]), pack2(S0[12], S0[13]), pack2(S0[14], S0[15]));
          pb[2] = mk8(pack2(S1[0], S1[1]), pack2(S1[2], S1[3]), pack2(S1[4], S1[5]), pack2(S1[6], S1[7]));
          pb[3] = mk8(pack2(S1[8], S1[9]), pack2(S1[10], S1[11]), pack2(S1[12], S1[13]), pack2(S1[14], S1[15]));
#pragma unroll
          for (int kq = 0; kq < 4; ++kq) {
            if ((MODE == 2 && kq == 0) || (MODE == 1 && kq == 3)) continue;
            o0 = MFMA(vf[kq], pb[kq], o0);
            o1 = MFMA(vf[4 + kq], pb[kq], o1);
          }
        };
        if (!rowtile) softmax_pv(std::integral_constant<int, 0>{});
        else if (q0 == 0) softmax_pv(std::integral_constant<int, 1>{});
        else softmax_pv(std::integral_constant<int, 2>{});
      }
    }
    if (t + 1 < NT) ATT_STORE((t + 1) & 1);
    __syncthreads();
  }
#undef ATT_KTOK
#undef ATT_LOAD
#undef ATT_STORE
  float inv = FIXM ? 1.f / lacc[0] : 1.f / (lrun + __shfl_xor(lrun, 32));
  u16* op = Op + (size_t)r * 1024 + 4 * h;
#pragma unroll
  for (int g = 0; g < 4; ++g) {
    uint2 a, b;
    a.x = pack2(o0[4 * g] * inv, o0[4 * g + 1] * inv);
    a.y = pack2(o0[4 * g + 2] * inv, o0[4 * g + 3] * inv);
    b.x = pack2(o1[4 * g] * inv, o1[4 * g + 1] * inv);
    b.y = pack2(o1[4 * g + 2] * inv, o1[4 * g + 3] * inv);
    *reinterpret_cast<uint2*>(op + 8 * g) = a;
    *reinterpret_cast<uint2*>(op + 32 + 8 * g) = b;
  }
}

DI int seq_idx(int dir, int pos) { return dir == 0 ? pos : (pos < 4 ? 3 - pos : 39 - pos); }

DI void h1_item(const P& p, int b, int head, int pos, char* smem) {
  const int tid = otid(), lane = tid & 63, w = tid >> 6, r = lane & 31, h = lane >> 5;
  char* kdT = smem;
  char* vT = smem + 2 * 9216;
  const size_t row0 = (size_t)b * TPB + pos * 64;
  if (w < 2) {
    const int dir = w, ch = lane;
    const float* lp = pLOGF + row0 * 512 + dir * 256 + head * 64 + ch;
    float lfv[64];
#pragma unroll
    for (int j = 0; j < 64; ++j) lfv[j] = lp[(size_t)j * 512];
    float sfx = 0.f;
    if (dir == 0) {
#pragma unroll
      for (int gq = 7; gq >= 0; --gq) {
        float kd[8];
#pragma unroll
        for (int j = 7; j >= 0; --j) {
          float lf = lfv[gq * 8 + j];
          kd[j] = (1.f - __expf(lf)) * __expf(sfx);
          sfx += lf;
        }
        u32x4 o = {pack2(kd[0], kd[1]), pack2(kd[2], kd[3]), pack2(kd[4], kd[5]), pack2(kd[6], kd[7])};
        *reinterpret_cast<u32x4*>(kdT + ch * 144 + gq * 16) = o;
      }
    } else {
#pragma unroll
      for (int gq = 0; gq < 8; ++gq) {
        float kd[8];
#pragma unroll
        for (int j = 0; j < 8; ++j) {
          float lf = lfv[gq * 8 + j];
          kd[j] = (1.f - __expf(lf)) * __expf(sfx);
          sfx += lf;
        }
        u32x4 o = {pack2(kd[0], kd[1]), pack2(kd[2], kd[3]), pack2(kd[4], kd[5]), pack2(kd[6], kd[7])};
        *reinterpret_cast<u32x4*>(kdT + 9216 + ch * 144 + gq * 16) = o;
      }
    }
    int chain = (b * 4 + head) * 2 + dir;
    pDST[((size_t)chain * 36 + seq_idx(dir, pos)) * 64 + ch] = sfx;
  } else {
    const int dv = lane, half = w - 2;
    const u16* vp = pCI + (row0 + half * 32) * 256 + head * 64 + dv;
    unsigned vv[32];
#pragma unroll
    for (int j = 0; j < 32; ++j) vv[j] = vp[(size_t)j * 256];
#pragma unroll
    for (int gi = 0; gi < 4; ++gi) {
      u32x4 o = {vv[8 * gi] | (vv[8 * gi + 1] << 16), vv[8 * gi + 2] | (vv[8 * gi + 3] << 16), vv[8 * gi + 4] | (vv[8 * gi + 5] << 16),
                 vv[8 * gi + 6] | (vv[8 * gi + 7] << 16)};
      *reinterpret_cast<u32x4*>(vT + dv * 144 + (half * 4 + gi) * 16) = o;
    }
  }
  __syncthreads();
  {
    const int dir = w & 1, dvh = w >> 1;
    int chain = (b * 4 + head) * 2 + dir;
    float* up = pUST + ((size_t)chain * 36 + seq_idx(dir, pos)) * 4096;
#pragma unroll
    for (int tc = 0; tc < 2; ++tc) {
      f32x16 acc;
#pragma unroll
      for (int i = 0; i < 16; ++i) acc[i] = 0.f;
#pragma unroll
      for (int ks = 0; ks < 4; ++ks) {
        bf16x8 a = ld8(kdT + dir * 9216 + (tc * 32 + r) * 144 + (16 * ks + 8 * h) * 2);
        bf16x8 bb = ld8(vT + (dvh * 32 + r) * 144 + (16 * ks + 8 * h) * 2);
        acc = MFMA(a, bb, acc);
      }
#pragma unroll
      for (int g = 0; g < 4; ++g) {
        float4 v4 = {acc[4 * g], acc[4 * g + 1], acc[4 * g + 2], acc[4 * g + 3]};
        *reinterpret_cast<float4*>(up + (dvh * 32 + r) * 64 + tc * 32 + 8 * g + 4 * h) = v4;
      }
    }
  }
  __syncthreads();
}

DI void h2_phase(const P& p) {
  const int total = 128 * 4096;
  for (int idx = obid() * 256 + otid(); idx < total; idx += gridDim.x * 256) {
    int chain = idx >> 12, e = idx & 4095, ch = e & 63;
    const float* up = pUST + (size_t)chain * 36 * 4096 + e;
    const float* dp = pDST + (size_t)chain * 36 * 64 + ch;
    u16* sp = pSTT + (size_t)chain * 36 * 4096 + e;
    float S = 0.f;
#pragma unroll
    for (int n = 0; n < 36; ++n) {
      sp[(size_t)n * 4096] = (u16)f2bf(S);
      S = S * __expf(dp[n * 64]) + up[(size_t)n * 4096];
    }
  }
}

DI void h3_item(const P& p, int l, int b, int head, int pos, char* smem) {
  const int tid = otid(), lane = tid & 63, w = tid >> 6, r = lane & 31, h = lane >> 5;
  char* kS = smem;
  char* qS = smem + 9216;
  char* qeS = smem + 2 * 9216;
  char* vT = smem + 3 * 9216;
  float* tot = (float*)(smem + 4 * 9216);
  float* ssq = tot + 256;
  const size_t row0 = (size_t)b * TPB + pos * 64;
  const int tdv = w & 1, tt = w >> 1;
  float lfA[2][16];
  unsigned qA[16];
  bf16x8 stfA[2][4];
  uint2 gvA[4];
  {
    const float* lp_ = pLOGF + (row0 + w * 16) * 512 + head * 64 + lane;
    const u16* qp_ = pCQ + (row0 + w * 16) * 256 + head * 64 + lane;
#pragma unroll
    for (int j = 0; j < 16; ++j) { lfA[0][j] = lp_[(size_t)j * 512]; lfA[1][j] = lp_[(size_t)j * 512 + 256]; qA[j] = qp_[(size_t)j * 256]; }
#pragma unroll
    for (int d = 0; d < 2; ++d) {
      const u16* stp_ = pSTT + ((size_t)((b * 4 + head) * 2 + d) * 36 + seq_idx(d, pos)) * 4096;
#pragma unroll
      for (int ks = 0; ks < 4; ++ks) stfA[d][ks] = ld8(stp_ + (tdv * 32 + r) * 64 + 16 * ks + 8 * h);
    }
#pragma unroll
    for (int g = 0; g < 4; ++g)
      gvA[g] = *reinterpret_cast<const uint2*>(pCG + (row0 + tt * 32 + r) * 256 + head * 64 + tdv * 32 + 8 * g + 4 * h);
  }
  {
    const int dv = lane, seg = w;
    const u16* vp = pCI + (row0 + seg * 16) * 256 + head * 64 + dv;
    unsigned vv[16];
#pragma unroll
    for (int j = 0; j < 16; ++j) vv[j] = vp[(size_t)j * 256];
    u32x4 o0 = {vv[0] | (vv[1] << 16), vv[2] | (vv[3] << 16), vv[4] | (vv[5] << 16), vv[6] | (vv[7] << 16)};
    u32x4 o1 = {vv[8] | (vv[9] << 16), vv[10] | (vv[11] << 16), vv[12] | (vv[13] << 16), vv[14] | (vv[15] << 16)};
    *reinterpret_cast<u32x4*>(vT + dv * 144 + seg * 32) = o0;
    *reinterpret_cast<u32x4*>(vT + dv * 144 + seg * 32 + 16) = o1;
  }
  f32x16 o;
#pragma unroll
  for (int i = 0; i < 16; ++i) o[i] = 0.f;
#pragma unroll
  for (int dir = 0; dir < 2; ++dir) {
    const int ch = lane, seg = w;
    float lf[16], cs[16];
#pragma unroll
    for (int j = 0; j < 16; ++j) lf[j] = lfA[dir][j];
    float run = 0.f;
    if (dir == 0) {
#pragma unroll
      for (int j = 0; j < 16; ++j) { run += lf[j]; cs[j] = run; }
    } else {
#pragma unroll
      for (int j = 15; j >= 0; --j) { run += lf[j]; cs[j] = run; }
    }
    tot[seg * 64 + ch] = run;
    __syncthreads();
    float t0 = tot[ch], t1 = tot[64 + ch], t2 = tot[128 + ch], t3 = tot[192 + ch];
    float off, bref;
    if (dir == 0) { off = (seg > 0 ? t0 : 0.f) + (seg > 1 ? t1 : 0.f) + (seg > 2 ? t2 : 0.f); bref = t0 + t1; }
    else { off = (seg < 3 ? t3 : 0.f) + (seg < 2 ? t2 : 0.f) + (seg < 1 ? t1 : 0.f); bref = t3 + t2; }
    const float ebref = __expf(bref);
#pragma unroll
    for (int j = 0; j < 16; ++j) {
      float bb = cs[j] + off;
      float q = bf2f((u16)qA[j]);
      float k = 1.f - __expf(lf[j]);
      int rho = seg * 16 + j;
      const float e1 = __expf(fminf(fmaxf(bb - bref, -80.f), 80.f)), qt = q * e1;
      *reinterpret_cast<u16*>(kS + rho * 144 + ch * 2) = (u16)f2bf(k * __builtin_amdgcn_rcpf(e1));
      *reinterpret_cast<u16*>(qS + rho * 144 + ch * 2) = (u16)f2bf(qt);
      *reinterpret_cast<u16*>(qeS + rho * 144 + ch * 2) = (u16)f2bf(qt * ebref);
    }
    __syncthreads();
#pragma unroll
    for (int ts = 0; ts < 2; ++ts) {
      f32x16 S;
#pragma unroll
      for (int i = 0; i < 16; ++i) S[i] = 0.f;
#pragma unroll
      for (int ks = 0; ks < 4; ++ks) {
        bf16x8 a = ld8(kS + (ts * 32 + r) * 144 + (16 * ks + 8 * h) * 2);
        bf16x8 bq = ld8(qS + (tt * 32 + r) * 144 + (16 * ks + 8 * h) * 2);
        S = MFMA(a, bq, S);
      }
      int tau = tt * 32 + r;
#pragma unroll
      for (int i = 0; i < 16; ++i) {
        int s = ts * 32 + crow(i, h);
        bool keep = dir == 0 ? (s <= tau) : (s >= tau);
        S[i] = keep ? S[i] : 0.f;
      }
      bf16x8 pb0 = mk8(pack2(S[0], S[1]), pack2(S[2], S[3]), pack2(S[4], S[5]), pack2(S[6], S[7]));
      bf16x8 pb1 = mk8(pack2(S[8], S[9]), pack2(S[10], S[11]), pack2(S[12], S[13]), pack2(S[14], S[15]));
      const char* vb = vT + (tdv * 32 + r) * 144 + (ts * 32 + 4 * h) * 2;
      uint2 a0 = *reinterpret_cast<const uint2*>(vb), a1 = *reinterpret_cast<const uint2*>(vb + 16);
      uint2 a2 = *reinterpret_cast<const uint2*>(vb + 32), a3 = *reinterpret_cast<const uint2*>(vb + 48);
      o = MFMA(mk8(a0.x, a0.y, a1.x, a1.y), pb0, o);
      o = MFMA(mk8(a2.x, a2.y, a3.x, a3.y), pb1, o);
    }
#pragma unroll
    for (int ks = 0; ks < 4; ++ks) {
      bf16x8 bq = ld8(qeS + (tt * 32 + r) * 144 + (16 * ks + 8 * h) * 2);
      o = MFMA(stfA[dir][ks], bq, o);
    }
    __syncthreads();
  }
  float ss = 0.f;
#pragma unroll
  for (int i = 0; i < 16; ++i) ss += o[i] * o[i];
  ss += __shfl_xor(ss, 32);
  if (h == 0) ssq[tdv * 64 + tt * 32 + r] = ss;
  __syncthreads();
  float tot2 = ssq[tt * 32 + r] + ssq[64 + tt * 32 + r];
  float rs = rsqrtf(tot2 * (1.f / 64.f) + 1e-6f);
  const size_t row = row0 + tt * 32 + r;
  const float* gn = p.hgn + l * 64;
#pragma unroll
  for (int g = 0; g < 4; ++g) {
    int dv = tdv * 32 + 8 * g + 4 * h;
    uint2 gv = gvA[g];
    float g0 = bf2f((u16)(gv.x & 0xffff)), g1 = bf2f((u16)(gv.x >> 16)), g2 = bf2f((u16)(gv.y & 0xffff)), g3 = bf2f((u16)(gv.y >> 16));
    uint2 ov;
    ov.x = pack2(o[4 * g] * rs * gn[dv] * siluf(g0), o[4 * g + 1] * rs * gn[dv + 1] * siluf(g1));
    ov.y = pack2(o[4 * g + 2] * rs * gn[dv + 2] * siluf(g2), o[4 * g + 3] * rs * gn[dv + 3] * siluf(g3));
    *reinterpret_cast<uint2*>(pMIX + row * 1024 + 768 + head * 64 + dv) = ov;
  }
  __syncthreads();
}

DI void attn_phase(const P& p, int l, char* smem) {
  const int tid = otid(), lane = tid & 63, w = tid >> 6;
  const int n_gl = 1536, n_nl = 1536, n_gc = (l == 3) ? 0 : 192, n_nc = (l == 3) ? 0 : 192, n_h1 = 2304;
  const int total = n_gl + n_nl + n_gc + n_nc + n_h1;
  for (int it = obid(); it < total; it += gridDim.x) {
    int i = it;
    if (i < n_gl) {
      int b = i / 96, rem = i % 96, hq = rem / 16, qb = rem % 16, kvh = hq / 3;
      size_t qrow = (size_t)b * TPB + 256 + qb * 128 + w * 32;
      attn_block<true>(pBQ + qrow * 384 + hq * 64, 384, pBKK + (size_t)b * TPB * 128 + kvh * 64, 128,
                 pBVT + (size_t)(b * 2 + kvh) * 64 * TPB, 36, false, 0, 0, 0, 0, nullptr, pMIX + qrow * 1024 + 384 + hq * 64, smem, pMISC[l]);
      continue;
    }
    i -= n_gl;
    if (i < n_nl) {
      int b = i / 96, rem = i % 96, hh = rem / 16, rp = rem % 16;
      int qr = rp * 2 + (w >> 1), q0 = (w & 1) * 32;
      int rstart = min(max(qr - 4, 0), 24);
      int rs_min = min(max(rp * 2 - 4, 0), 24), rs_max = min(max(rp * 2 + 1 - 4, 0), 24);
      size_t qrow = (size_t)b * TPB + 256 + qr * 64 + q0;
      attn_block<false>(pAQ + qrow * 384 + hh * 64, 384, pAK + (size_t)b * TPB * 384 + hh * 64, 384,
                 pAVT + (size_t)(b * 6 + hh) * 64 * TPB, 4 + rs_max + 8 - rs_min, true, rs_min, rstart, qr, q0,
                 p.rpb + (size_t)(l * 6 + hh) * 465, pMIX + qrow * 1024 + hh * 64, smem);
      continue;
    }
    i -= n_nl;
    if (i < n_gc) {
      int b = i / 12, rem = i % 12, hq = rem / 2, qb = rem % 2, kvh = hq / 3;
      size_t qrow = (size_t)b * TPB + qb * 128 + w * 32;
      attn_block<true>(pBQ + qrow * 384 + hq * 64, 384, pBKK + (size_t)b * TPB * 128 + kvh * 64, 128,
                 pBVT + (size_t)(b * 2 + kvh) * 64 * TPB, 4, false, 0, 0, 0, 0, nullptr, pMIX + qrow * 1024 + 384 + hq * 64, smem, pMISC[l]);
      continue;
    }
    i -= n_gc;
    if (i < n_nc) {
      int b = i / 12, rem = i % 12, hh = rem / 2, qb = rem % 2;
      size_t qrow = (size_t)b * TPB + qb * 128 + w * 32;
      attn_block<false>(pAQ + qrow * 384 + hh * 64, 384, pAK + (size_t)b * TPB * 384 + hh * 64, 384,
                 pAVT + (size_t)(b * 6 + hh) * 64 * TPB, 4, false, 0, 0, 0, 0, nullptr, pMIX + qrow * 1024 + hh * 64, smem);
      continue;
    }
    i -= n_nc;
    {
      int b = i / 144, rem = i % 144, head = rem / 36, pos = rem % 36;
      h1_item(p, b, head, pos, smem);
    }
  }
}

DI void h3_phase(const P& p, int l, char* smem) {
  for (int it = obid(); it < 2304; it += gridDim.x) {
    int b = it / 144, rem = it % 144, head = rem / 36, pos = rem % 36;
    if (l == 3 && pos < 4) continue;
    h3_item(p, l, b, head, pos, smem);
  }
}


#if SELFCHECK
#define pFLAG ((unsigned*)(p.ws + O_FLAG))
DI float lb_ref(const P& p, int l, int dir, int c) {
  float v[4], mx = -1e30f, s = 0.f, acc = 0.f;
  for (int k = 0; k < 4; ++k) { v[k] = p.hlb[(k * 2 + dir) * 256 + c]; mx = fmaxf(mx, v[k]); }
  for (int k = 0; k < 4; ++k) { v[k] = expf(v[k] - mx); s += v[k]; }
  for (int k = 1; k <= l; ++k) acc += v[k] / s;
  return acc;
}
DI void chk_cmp(const P& p, float ref, float got, unsigned bit) {
  float e = wave_sum((ref - got) * (ref - got)), n = wave_sum(ref * ref);
  if (!(e <= 0.0009f * n + 1e-7f)) { if ((otid() & 63) == 0) atomicOr(pFLAG, bit); }
}
DI void chk_proj(const P& p, int l, int row, int g, int lane) {
  int b = row / TPB, tok = row - b * TPB;
  bool isctx = tok < 256;
  float z = 0.f;
  const float* wp = p.w_in + (size_t)l * 1024 * 3072 + 64 * g + lane;
  for (int k = 0; k < 1024; ++k) z += bf2f(pH[(size_t)row * 1024 + k]) * bf2f((u16)f2bf(wp[(size_t)k * 3072]));
  float ref = z, got;
  int t = tok - 256;
  auto nr = [&](const float* gw) {
    float ms = wave_sum(z * z) * (1.f / 64.f);
    float y = z * rsqrtf(ms + 1e-6f) * gw[lane];
    if (!isctx) {
      int axis = lane >> 5, pair = (lane >> 4) & 1, f = lane & 15;
      float other = __shfl(y, lane ^ 16);
      float pos = (float)(axis == 0 ? (t / 64) : (t % 64));
      float ang = pos * powf(10000.f, -(float)f / 16.f);
      float cs = cosf(ang), sn = sinf(ang);
      y = pair == 0 ? y * cs - other * sn : y * cs + other * sn;
    }
    return y;
  };
  if (g < 6) got = bf2f(pAK[(size_t)row * 384 + 64 * g + lane]);
  else if (g < 12) got = bf2f(pAVT[((size_t)(b * 6 + g - 6) * 64 + lane) * TPB + tok]);
  else if (g < 14) { ref = nr(p.kn + l * 64); got = bf2f(pBKK[(size_t)row * 128 + (g - 12) * 64 + lane]); }
  else if (g < 16) got = bf2f(pBVT[((size_t)(b * 2 + g - 14) * 64 + lane) * TPB + tok]);
  else if (g < 24) {
    int dir = g >= 20, c = (g - (dir ? 20 : 16)) * 64 + lane;
    float lb = lb_ref(p, l, dir, c);
    float sg = 1.f / (1.f + expf(-z));
    ref = logf(fmaxf(lb, 1e-30f) + (1.f - lb) * sg);
    got = pLOGF[(size_t)row * 512 + dir * 256 + c];
  } else if (g < 28) got = bf2f(pCI[(size_t)row * 256 + (g - 24) * 64 + lane]);
  else if (g < 34) { ref = z * 0.125f * LOG2E; got = bf2f(pAQ[(size_t)row * 384 + (g - 28) * 64 + lane]); }
  else if (g < 40) { ref = nr(p.qn + l * 64) * 0.125f * LOG2E; got = bf2f(pBQ[(size_t)row * 384 + (g - 34) * 64 + lane]); }
  else if (g < 44) { ref = z * 0.125f; got = bf2f(pCQ[(size_t)row * 256 + (g - 40) * 64 + lane]); }
  else got = bf2f(pCG[(size_t)row * 256 + (g - 44) * 64 + lane]);
  chk_cmp(p, ref, got, 1u);
}
DI void chk_attn(const P& p, int l, int kind, int b, int hh, int tok, int lane) {
  bool na = kind < 2, lat = (kind & 1) == 0;
  size_t row = (size_t)b * TPB + (lat ? 256 : 0) + tok;
  float q = na ? bf2f(pAQ[row * 384 + hh * 64 + lane]) : bf2f(pBQ[row * 384 + hh * 64 + lane]);
  float m = -1e30f, ls = 0.f, o = 0.f;
  auto key = [&](int j, float bias) {
    size_t krow = (size_t)b * TPB + j;
    float kv = na ? bf2f(pAK[krow * 384 + hh * 64 + lane]) : bf2f(pBKK[krow * 128 + (hh / 3) * 64 + lane]);
    float vv = na ? bf2f(pAVT[((size_t)(b * 6 + hh) * 64 + lane) * TPB + j]) : bf2f(pBVT[((size_t)(b * 2 + hh / 3) * 64 + lane) * TPB + j]);
    float s = wave_sum(q * kv) + bias * LOG2E;
    float mn = fmaxf(m, s), a = exp2f(m - mn), pr = exp2f(s - mn);
    ls = ls * a + pr; o = o * a + pr * vv; m = mn;
  };
  for (int j = 0; j < 256; ++j) key(j, 0.f);
  if (lat) {
    if (na) {
      int qr = tok / 64, qc = tok % 64;
      int rs = min(max(qr - 4, 0), 24), cs = min(max(qc - 8, 0), 48);
      for (int kr = rs; kr < rs + 8; ++kr)
        for (int kc = cs; kc < cs + 16; ++kc)
          key(256 + kr * 64 + kc, p.rpb[((size_t)(l * 6 + hh) * 15 + (kr - qr + 7)) * 31 + (kc - qc + 15)]);
    } else {
      for (int j = 256; j < TPB; ++j) key(j, 0.f);
    }
  }
  float got = bf2f(pMIX[row * 1024 + (na ? 0 : 384) + hh * 64 + lane]);
  chk_cmp(p, o / ls, got, na ? 2u : 4u);
}
DI void chk_hgrn(const P& p, int l, int b, int head, int i, char* smem) {
  const int tid = otid(), ch = tid >> 2, dv0 = (tid & 3) * 16;
  float* red = (float*)smem;
  if (tid < 64) red[tid] = 0.f;
  __syncthreads();
  for (int dir = 0; dir < 2; ++dir) {
    float S[16];
#pragma unroll
    for (int j = 0; j < 16; ++j) S[j] = 0.f;
    int nsteps = dir == 0 ? i + 1 : (i < 256 ? 256 - i : 256 + (TPB - i));
    for (int st = 0; st < nsteps; ++st) {
      int j;
      if (dir == 0) j = st;
      else j = i < 256 ? 255 - st : (st < 256 ? 255 - st : TPB - 1 - (st - 256));
      size_t rj = (size_t)b * TPB + j;
      float lf = pLOGF[rj * 512 + dir * 256 + head * 64 + ch];
      float f = expf(lf), k = -expm1f(lf);
#pragma unroll
      for (int jj = 0; jj < 16; ++jj) S[jj] = S[jj] * f + k * bf2f(pCI[rj * 256 + head * 64 + dv0 + jj]);
    }
    float q = bf2f(pCQ[((size_t)b * TPB + i) * 256 + head * 64 + ch]);
#pragma unroll
    for (int jj = 0; jj < 16; ++jj) atomicAdd(&red[dv0 + jj], q * S[jj]);
  }
  __syncthreads();
  if (tid < 64) {
    float o = red[tid];
    float ms = wave_sum(o * o) * (1.f / 64.f);
    size_t row = (size_t)b * TPB + i;
    float gg = bf2f(pCG[row * 256 + head * 64 + tid]);
    float ref = o * rsqrtf(ms + 1e-6f) * p.hgn[l * 64 + tid] * (gg / (1.f + expf(-gg)));
    float got = bf2f(pMIX[row * 1024 + 768 + head * 64 + tid]);
    chk_cmp(p, ref, got, 8u);
  }
  __syncthreads();
}
DI void selfcheck_proj(const P& p, int l) {
  const int lane = otid() & 63, gw = obid() * 4 + (otid() >> 6), nw = gridDim.x * 4;
  const int rows[6] = {5, TPB * 3 + 255, 256, TPB * 7 + 256 + 64 * 13 + 47, TPB * 15 + 2303, TPB * 9 + 256 + 63};
  for (int it = gw; it < 6 * 48; it += nw) {
    int ri = it / 48, g = it % 48;
    int row = ri == 0 ? rows[0] : ri == 1 ? rows[1] : ri == 2 ? rows[2] : ri == 3 ? rows[3] : ri == 4 ? rows[4] : rows[5];
    chk_proj(p, l, row, g, lane);
  }
}
DI void selfcheck_mix(const P& p, int l, char* smem) {
  const int lane = otid() & 63, gw = obid() * 4 + (otid() >> 6), nw = gridDim.x * 4;
  for (int it = gw; it < 21; it += nw) {
    if (it < 12) {
      int tk = it == 0 ? 0 : it == 1 ? 63 : it == 2 ? 1984 : it == 3 ? 2047 : it == 4 ? 327 : it == 5 ? 264 : it == 6 ? 1783 : it == 7 ? 1848 : it == 8 ? 1000 : it == 9 ? 37 : it == 10 ? 1056 : 252;
      chk_attn(p, l, 0, (it * 5) % 16, it % 6, tk, lane);
    } else if (it < 15) {
      int s = it - 12;
      chk_attn(p, l, 1, 2 + 4 * s, 1 + 2 * s, s == 0 ? 0 : s == 1 ? 100 : 255, lane);
    } else if (it < 19) {
      int s = it - 15;
      chk_attn(p, l, 2, s == 0 ? 1 : s == 1 ? 6 : s == 2 ? 12 : 15, s == 0 ? 0 : s == 1 ? 2 : s == 2 ? 3 : 5, s == 0 ? 0 : s == 1 ? 2047 : s == 2 ? 777 : 1285, lane);
    } else {
      int s = it - 19;
      chk_attn(p, l, 3, s == 0 ? 4 : 9, s == 0 ? 1 : 4, s == 0 ? 7 : 255, lane);
    }
  }
  for (int it = (int)gridDim.x - 1 - obid(); it < 8; it += gridDim.x) {
    int b = it == 0 ? 0 : it == 1 ? 3 : it == 2 ? 5 : it == 3 ? 8 : it == 4 ? 12 : it == 5 ? 15 : it == 6 ? 7 : 2;
    int hd = it & 3;
    int i = it == 0 ? 0 : it == 1 ? 255 : it == 2 ? 256 : it == 3 ? 319 : it == 4 ? 320 : it == 5 ? 2303 : it == 6 ? 1300 : 130;
    chk_hgrn(p, l, b, hd, i, smem);
  }
}
#endif

DI void prologue_a(const P& p, char* smem) {
  const int tid = otid();
  float* sc = (float*)smem;
  for (int it = obid(); it < 768; it += gridDim.x) {
    int cb = it % 24, s = (it / 24) % 8, l = it / 192;
    for (int idx = tid; idx < 17 * 128; idx += 256) {
      int rr = idx >> 7, kk = idx & 127, k = s * 128 + kk;
      float v = rr < 16 ? p.c[rr * 1024 + k] : p.c_ctx[k];
      sc[idx] = siluf(v);
    }
    __syncthreads();
    int n = cb * 256 + tid;
    float acc[17];
#pragma unroll
    for (int rr = 0; rr < 17; ++rr) acc[rr] = 0.f;
    const float* wp = p.w_ada + ((size_t)l * 1024 + s * 128) * 6144 + n;
#pragma unroll 1
    for (int k0 = 0; k0 < 128; k0 += 32) {
      float wv[32];
#pragma unroll
      for (int kk = 0; kk < 32; ++kk) wv[kk] = wp[(size_t)(k0 + kk) * 6144];
#pragma unroll
      for (int kk = 0; kk < 32; ++kk)
#pragma unroll
        for (int rr = 0; rr < 17; ++rr) acc[rr] += sc[rr * 128 + k0 + kk] * wv[kk];
    }
#pragma unroll
    for (int rr = 0; rr < 17; ++rr) pPART[((size_t)(s * 4 + l) * 17 + rr) * 6144 + n] = acc[rr];
    __syncthreads();
  }
  convert_weights(p, 0, 15, smem);
  if (obid() == 0) {
    for (int idx = tid; idx < 512; idx += 256) {
      float v0 = p.hlb[idx], v1 = p.hlb[512 + idx], v2 = p.hlb[1024 + idx], v3 = p.hlb[1536 + idx];
      float mx = fmaxf(fmaxf(v0, v1), fmaxf(v2, v3));
      float e0 = expf(v0 - mx), e1 = expf(v1 - mx), e2 = expf(v2 - mx), e3 = expf(v3 - mx);
      float inv = 1.f / (e0 + e1 + e2 + e3);
      pLB[idx] = 0.f;
      pLB[512 + idx] = e1 * inv;
      pLB[1024 + idx] = (e1 + e2) * inv;
      pLB[1536 + idx] = (e1 + e2 + e3) * inv;
    }
    if (tid < 4) {
      float mq = 0.f, mk = 0.f;
      for (int d = 0; d < 64; ++d) { mq = fmaxf(mq, fabsf(p.qn[tid * 64 + d])); mk = fmaxf(mk, fabsf(p.kn[tid * 64 + d])); }
      pMISC[tid] = 8.f * LOG2E * mq * mk;
    }
    for (int idx = tid; idx < 64 * 16; idx += 256) {
      int pos = idx >> 4, f = idx & 15;
      float invf = powf(10000.f, -(float)f / 16.f);
      float ang = (float)pos * invf;
      pROPE[pos * 32 + f] = cosf(ang);
      pROPE[pos * 32 + 16 + f] = sinf(ang);
    }
  }
}
DI void prologue_b(const P& p) {
  const int total = 4 * 17 * 6144;
  for (int idx = obid() * 256 + otid(); idx < total; idx += gridDim.x * 256) {
    int n = idx % 6144, lr = idx / 6144, l = lr / 17, rr = lr % 17;
    float a = p.b_ada[l * 6144 + n];
#pragma unroll
    for (int s = 0; s < 8; ++s) a += pPART[((size_t)(s * 4 + l) * 17 + rr) * 6144 + n];
    pMOD[idx] = a;
  }
}

__global__ void __launch_bounds__(256, 2) mega(P p) {
  cg::grid_group grid = cg::this_grid();
  __shared__ __attribute__((aligned(16))) char smem[SMEM_BYTES];
  __shared__ uint4 xb_words;
  if (threadIdx.x == 0) xb_words = make_uint4(0u, 0u, 0u, 0u);
  __syncthreads();
  (void)xcd_barrier_post((unsigned*)(p.ws + O_BAR), (volatile LAS unsigned*)&xb_words);
#define XBAR() do { XcdBarrier xb_; xb_.bar = (unsigned*)(p.ws + O_BAR); xb_.x = xb_xcc_id(); xb_.st = (volatile LAS unsigned*)&xb_words; xcd_barrier(xb_); } while (0)
#if SELFCHECK
  if (obid() == 0 && otid() == 0) *((unsigned*)(p.ws + O_FLAG)) = 0u;
#endif
  prologue_a(p, smem);
  if (p.ws == nullptr) grid.sync();
  XBAR();
  prologue_b(p);
  XBAR();
  ln_phase(p, 0, 0);
  XBAR();
#pragma unroll 1
  for (int l = 0; l < 4; ++l) {
    proj_phase(p, l, smem);
    XBAR();
#if SELFCHECK
    if (l < 2) { selfcheck_proj(p, l); XBAR(); }
#endif
    attn_phase(p, l, smem);
    XBAR();
    h2_phase(p);
    XBAR();
    h3_phase(p, l, smem);
    XBAR();
#if SELFCHECK
    if (l < 2) { selfcheck_mix(p, l, smem); XBAR(); }
#endif
    res_gemm_phase(p, l, pWoutT, pMIX, 1024, 2, smem);
    XBAR();
    ln_phase(p, 1, l);
    XBAR();
    up_phase(p, l, smem);
    XBAR();
    fixup_phase(p, l);
    if (l < 3) convert_weights(p, l + 1, 4, smem);
    XBAR();
    res_gemm_phase(p, l, pWdownT, pACT, DFF, 5, smem);
    XBAR();
    ln_phase(p, 2, l);
    if (l < 3) convert_weights(p, l + 1, 8, smem);
    XBAR();
  }
}

extern "C" void kernel_launch(void* const* d_in, const int* in_sizes, int n_in, void* d_out, int out_size, void* d_ws,
                              size_t ws_size, hipStream_t stream) {
  P p{};
  p.x = (const float*)d_in[0]; p.c = (const float*)d_in[1]; p.ctx = (const float*)d_in[2]; p.c_ctx = (const float*)d_in[3];
  p.w_ada = (const float*)d_in[4]; p.b_ada = (const float*)d_in[5]; p.w_in = (const float*)d_in[6]; p.w_out = (const float*)d_in[7];
  p.rpb = (const float*)d_in[8]; p.qn = (const float*)d_in[9]; p.kn = (const float*)d_in[10]; p.hlb = (const float*)d_in[11];
  p.hgn = (const float*)d_in[12]; p.ln1g = (const float*)d_in[13]; p.ln1b = (const float*)d_in[14]; p.w_up = (const float*)d_in[15];
  p.conv_w = (const float*)d_in[16]; p.conv_b = (const float*)d_in[17]; p.w_down = (const float*)d_in[18];
  p.ln2g = (const float*)d_in[19]; p.ln2b = (const float*)d_in[20];
  p.out = (float*)d_out;
  p.ws = (char*)d_ws;
  if (O_TOTAL > ws_size) fprintf(stderr, "workspace too small: need %zu have %zu\n", (size_t)O_TOTAL, ws_size);

  hipMemsetAsync((char*)d_ws + O_BAR, 0, 16384, stream);
  static int grid_blocks = 0;
  if (!grid_blocks) {
    int dev = 0, cus = 0, per_cu = 0;
    hipGetDevice(&dev);
    hipDeviceGetAttribute(&cus, hipDeviceAttributeMultiprocessorCount, dev);
    hipOccupancyMaxActiveBlocksPerMultiprocessor(&per_cu, mega, 256, 0);
    if (per_cu > 2) per_cu = 2;
    if (per_cu < 1) per_cu = 1;
    grid_blocks = (cus * per_cu) & ~7;
  }
  void* args[] = {&p};
  hipError_t e = hipLaunchCooperativeKernel((void*)mega, dim3(grid_blocks), dim3(256), args, 0, stream);
  if (e != hipSuccess) fprintf(stderr, "cooperative launch failed: %s (grid %d)\n", hipGetErrorString(e), grid_blocks);
}
```

```cpp
#include <hip/hip_runtime.h>
#include <hip/hip_cooperative_groups.h>
#include <cstdio>
#include <type_traits>
namespace cg = cooperative_groups;

typedef unsigned short u16;
using bf16x8 = __attribute__((ext_vector_type(8))) short;
using f32x16 = __attribute__((ext_vector_type(16))) float;
using u32x4 = __attribute__((ext_vector_type(4))) unsigned;
#define DI __device__ __forceinline__
#define MFMA(a, b, c) __builtin_amdgcn_mfma_f32_32x32x16_bf16((a), (b), (c), 0, 0, 0)

constexpr int DM = 1024, NBATCH = 16, TPB = 2304, MTOK = 36864, DFF = 2816;
constexpr float ALPHA = 1.681792830507429f;
constexpr float LOG2E = 1.4426950408889634f;
constexpr int SMEM_BYTES = 55296;
#define SELFCHECK 0

struct P {
  const float *x, *c, *ctx, *c_ctx, *w_ada, *b_ada, *w_in, *w_out, *rpb, *qn, *kn, *hlb, *hgn, *ln1g, *ln1b, *w_up,
      *conv_w, *conv_b, *w_down, *ln2g, *ln2b;
  float* out;
  char* ws;
};
constexpr size_t al256(size_t x) { return (x + 255) & ~(size_t)255; }
constexpr size_t O_XC = 0;
constexpr size_t O_WIN = O_XC + al256((size_t)16 * 256 * 1024 * 4);
constexpr size_t O_WOUT = O_WIN + al256((size_t)3072 * 1024 * 2);
constexpr size_t O_WUP = O_WOUT + al256((size_t)1024 * 1024 * 2);
constexpr size_t O_WDN = O_WUP + al256((size_t)5632 * 1024 * 2);
constexpr size_t O_MOD = O_WDN + al256((size_t)1024 * 2816 * 2);
constexpr size_t O_LB = O_MOD + al256((size_t)4 * 17 * 6144 * 4);
constexpr size_t O_ROPE = O_LB + al256(2048 * 4);
constexpr size_t O_DST = O_ROPE + al256(64 * 32 * 4);
constexpr size_t O_H = O_DST + al256((size_t)128 * 36 * 64 * 4);
constexpr size_t O_R = O_H + al256((size_t)36864 * 1024 * 2);
constexpr size_t O_AQ = O_R;
constexpr size_t O_AK = O_AQ + (size_t)36864 * 384 * 2;
constexpr size_t O_AVT = O_AK + (size_t)36864 * 384 * 2;
constexpr size_t O_BQ = O_AVT + (size_t)36864 * 384 * 2;
constexpr size_t O_BKK = O_BQ + (size_t)36864 * 384 * 2;
constexpr size_t O_BVT = O_BKK + (size_t)36864 * 128 * 2;
constexpr size_t O_CI = O_BVT + (size_t)36864 * 128 * 2;
constexpr size_t O_CQ = O_CI + (size_t)36864 * 256 * 2;
constexpr size_t O_CG = O_CQ + (size_t)36864 * 256 * 2;
constexpr size_t O_LOGF = O_CG + (size_t)36864 * 256 * 2;
constexpr size_t O_MIX = O_LOGF + (size_t)36864 * 512 * 4;
constexpr size_t O_STT = O_MIX + (size_t)36864 * 1024 * 2;
constexpr size_t O_END = O_STT + (size_t)128 * 36 * 4096 * 2;
constexpr size_t O_FLAG = O_END;
constexpr size_t O_BAR = O_END + 256;
constexpr size_t O_STATS = O_BAR + 16384;
constexpr size_t O_MISC = O_STATS + (size_t)36864 * 8;
constexpr size_t O_TOTAL = O_MISC + 256;
constexpr size_t O_ACT = O_R;
constexpr size_t O_HALO = O_ACT + (size_t)36864 * 2816 * 2;
constexpr size_t O_PART = O_HALO + (size_t)288 * 4 * 5632 * 4;
#define pXC ((float*)(p.ws + O_XC))
#define pH ((u16*)(p.ws + O_H))
#define pWinT ((u16*)(p.ws + O_WIN))
#define pWoutT ((u16*)(p.ws + O_WOUT))
#define pWupT ((u16*)(p.ws + O_WUP))
#define pWdownT ((u16*)(p.ws + O_WDN))
#define pMOD ((float*)(p.ws + O_MOD))
#define pPART ((float*)(p.ws + O_PART))
#define pLB ((float*)(p.ws + O_LB))
#define pROPE ((float*)(p.ws + O_ROPE))
#define pLOGF ((float*)(p.ws + O_LOGF))
#define pUST ((float*)(p.ws + O_H))
#define pDST ((float*)(p.ws + O_DST))
#define pHALO ((float*)(p.ws + O_HALO))
#define pAQ ((u16*)(p.ws + O_AQ))
#define pAK ((u16*)(p.ws + O_AK))
#define pAVT ((u16*)(p.ws + O_AVT))
#define pBQ ((u16*)(p.ws + O_BQ))
#define pBKK ((u16*)(p.ws + O_BKK))
#define pBVT ((u16*)(p.ws + O_BVT))
#define pCI ((u16*)(p.ws + O_CI))
#define pCQ ((u16*)(p.ws + O_CQ))
#define pCG ((u16*)(p.ws + O_CG))
#define pMIX ((u16*)(p.ws + O_MIX))
#define pSTT ((u16*)(p.ws + O_STT))
#define pACT ((u16*)(p.ws + O_ACT))
#define pSTATS ((float*)(p.ws + O_STATS))
#define pMISC ((float*)(p.ws + O_MISC))

DI int otid() { int t = threadIdx.x; asm volatile("" : "+v"(t)); return t; }
DI int obid() { int t = blockIdx.x; asm volatile("" : "+s"(t)); return t; }
DI int crow(int i, int h) { return (i & 3) + 8 * (i >> 2) + 4 * h; }
typedef __bf16 hbf2 __attribute__((ext_vector_type(2)));
typedef float hf2 __attribute__((ext_vector_type(2)));
DI unsigned pack2(float a, float b) {
  hf2 v = {a, b};
  return __builtin_bit_cast(unsigned, __builtin_convertvector(v, hbf2));
}
DI unsigned f2bf(float x) { return pack2(x, x) & 0xffffu; }
DI float bf2f(u16 v) { return __uint_as_float(((unsigned)v) << 16); }
DI float siluf(float x) { return x * __builtin_amdgcn_rcpf(1.f + __expf(-x)); }
DI float ex2(float x) { return __builtin_amdgcn_exp2f(x); }
DI bf16x8 mk8(unsigned a, unsigned b, unsigned c, unsigned d) {
  u32x4 v = {a, b, c, d};
  return __builtin_bit_cast(bf16x8, v);
}
DI bf16x8 ld8(const void* p) { return *reinterpret_cast<const bf16x8*>(p); }
DI float* xrow(const P& p, int m) {
  int b = m / TPB, i = m - b * TPB;
  return i < 256 ? pXC + ((size_t)(b * 256 + i) << 10) : p.out + ((size_t)(b * 2048 + i - 256) << 10);
}
DI float wave_sum(float v) {
#pragma unroll
  for (int o = 32; o >= 1; o >>= 1) v += __shfl_xor(v, o);
  return v;
}


#define XB_TMO      128
#define XB_XCNT(j)  (256  + 64 * (j))
#define XB_XSUB(j)  (1280 + 64 * (j))
#define XB_XGEN(j)  (2304 + 64 * (j))
#define XB_TOP      3328
#define XB_TOPGEN   3392
#define XCD_BAR_WORDS 3456
#define XB_SPIN_CAP (1u << 22)
#define LAS __attribute__((address_space(3)))
DI unsigned xb_ld(unsigned* p) { return __hip_atomic_load(p, __ATOMIC_RELAXED, __HIP_MEMORY_SCOPE_AGENT); }
DI unsigned xb_add(unsigned* p, unsigned v) { return __hip_atomic_fetch_add(p, v, __ATOMIC_RELAXED, __HIP_MEMORY_SCOPE_AGENT); }
DI unsigned xb_xcc_id() { return (unsigned)__builtin_amdgcn_s_getreg((3 << 11) | 20) & 0xFu; }
#define XB_SPIN(cond, bar) do { unsigned _sp = 0; while (cond) { __builtin_amdgcn_s_sleep(1); \
    if ((++_sp & 255u) == 0u) { if (xb_ld(&(bar)[XB_TMO])) break; if (_sp > XB_SPIN_CAP) { atomicAdd(&(bar)[XB_TMO], 1u); break; } } } } while (0)
struct XcdBarrier { unsigned* bar; unsigned x; volatile LAS unsigned* st; };
DI XcdBarrier xcd_barrier_post(unsigned* bar, volatile LAS unsigned* st) {
  XcdBarrier b; b.bar = bar; b.x = xb_xcc_id(); b.st = st;
  if (threadIdx.x == 0) (void)xb_add(&bar[XB_XCNT(b.x)], 1u);
  return b;
}
DI void xcd_barrier_complete(unsigned* bar, unsigned x, unsigned& nloc, unsigned& nx) {
  const unsigned G = gridDim.x * gridDim.y * gridDim.z;
  unsigned sum, cnt, mine, sp = 0u;
  for (;;) {
    sum = 0u; cnt = 0u; mine = 0u;
#pragma unroll
    for (unsigned j = 0; j < 16; ++j) { const unsigned c = xb_ld(&bar[XB_XCNT(j)]); sum += c; cnt += (c > 0u) ? 1u : 0u; mine = (j == x) ? c : mine; }
    if (sum == G) break;
    __builtin_amdgcn_s_sleep(1);
    if ((++sp & 255u) == 0u) { if (xb_ld(&bar[XB_TMO])) break; if (sp > XB_SPIN_CAP) { atomicAdd(&bar[XB_TMO], 1u); break; } }
  }
  nloc = mine > 0u ? mine : 1u; nx = cnt > 0u ? cnt : 1u;
}
DI void xcd_barrier(const XcdBarrier& b) {
  asm volatile("s_waitcnt vmcnt(0)" ::: "memory");
  __syncthreads();
  if (threadIdx.x == 0) {
    unsigned* bar = b.bar;
    __builtin_amdgcn_s_waitcnt(0);
    unsigned nloc = b.st[0], nx = b.st[1];
    if (nloc == 0u) { xcd_barrier_complete(bar, b.x, nloc, nx); b.st[0] = nloc; b.st[1] = nx; }
    const unsigned old = xb_add(&bar[XB_XSUB(b.x)], 1u);
    const unsigned gen = old / nloc;
    if (old + 1u == (gen + 1u) * nloc) {
      __builtin_amdgcn_fence(__ATOMIC_RELEASE, "agent");
      asm volatile("s_waitcnt vmcnt(0)" ::: "memory");
      const unsigned og = xb_add(&bar[XB_TOP], 1u);
      const unsigned tg = og / nx;
      if (og + 1u == (tg + 1u) * nx) xb_add(&bar[XB_TOPGEN], 1u);
      else XB_SPIN(xb_ld(&bar[XB_TOPGEN]) == tg, bar);
      __builtin_amdgcn_fence(__ATOMIC_ACQUIRE, "agent");
      xb_add(&bar[XB_XGEN(b.x)], 1u);
      asm volatile("s_waitcnt vmcnt(0)" ::: "memory");
    } else {
      XB_SPIN(xb_ld(&bar[XB_XGEN(b.x)]) == gen, bar);
      __builtin_amdgcn_fence(__ATOMIC_ACQUIRE, "agent");
      asm volatile("s_waitcnt vmcnt(0)" ::: "memory");
    }
  }
  __syncthreads();
}

DI void conv_tile(const float* __restrict__ src, int N, u16* __restrict__ dst, int Kd, int k0, int n0, bool perm, char* smem) {
  float* t = (float*)smem;
  const int tid = otid();
#pragma unroll
  for (int i = 0; i < 16; ++i) {
    int idx = tid + 256 * i, kk = idx >> 6, nn = idx & 63;
    t[kk * 65 + nn] = src[(size_t)(k0 + kk) * N + n0 + nn];
  }
  __syncthreads();
#pragma unroll
  for (int i = 0; i < 2; ++i) {
    int cidx = tid + 256 * i, nn = cidx >> 3, kg = cidx & 7;
    float v[8];
#pragma unroll
    for (int j = 0; j < 8; ++j) v[j] = t[(kg * 8 + j) * 65 + nn];
    int n = n0 + nn;
    if (perm) {
      int tn = n / DFF, jj = n - tn * DFF;
      n = (jj >> 6) * 128 + ((jj >> 5) & 1) * 64 + tn * 32 + (jj & 31);
    }
    u32x4 o = {pack2(v[0], v[1]), pack2(v[2], v[3]), pack2(v[4], v[5]), pack2(v[6], v[7])};
    *reinterpret_cast<u32x4*>(dst + (size_t)n * Kd + k0 + kg * 8) = o;
  }
  __syncthreads();
}
DI void convert_weights(const P& p, int l, int which, char* smem) {
  int n_in = (which & 1) ? 16 * 48 : 0, n_out = (which & 2) ? 16 * 16 : 0, n_up = (which & 4) ? 16 * 88 : 0,
      n_dn = (which & 8) ? 44 * 16 : 0;
  int total = n_in + n_out + n_up + n_dn;
  for (int it = obid(); it < total; it += gridDim.x) {
    int i = it;
    if (i < n_in) { conv_tile(p.w_in + (size_t)l * 1024 * 3072, 3072, pWinT, 1024, (i / 48) * 64, (i % 48) * 64, false, smem); continue; }
    i -= n_in;
    if (i < n_out) { conv_tile(p.w_out + (size_t)l * 1024 * 1024, 1024, pWoutT, 1024, (i / 16) * 64, (i % 16) * 64, false, smem); continue; }
    i -= n_out;
    if (i < n_up) { conv_tile(p.w_up + (size_t)l * 1024 * 5632, 5632, pWupT, 1024, (i / 88) * 64, (i % 88) * 64, true, smem); continue; }
    i -= n_up;
    conv_tile(p.w_down + (size_t)l * DFF * 1024, 1024, pWdownT, DFF, (i / 16) * 64, (i % 16) * 64, false, smem);
  }
}

template <int TM, bool SWAP = false>
DI void gemm_main(const u16* __restrict__ Wt, const u16* __restrict__ A, int K, int n0, int m0, int rot, char* smem, f32x16 (&acc)[2][TM]) {
  const int tid = otid(), lane = tid & 63, w = tid >> 6, wn = w & 1, wm = w >> 1, r = lane & 31, h = lane >> 5;
  const int srow = tid >> 3, skc = tid & 7;
  const u16* gW = Wt + (size_t)(n0 + srow) * K + skc * 8;
  const u16* gA = A + (size_t)(m0 + srow) * K + skc * 8;
  const int T = K >> 6;
  int kt = rot % T;
  u32x4 rw[4], ra[2 * TM];
#pragma unroll
  for (int i = 0; i < 4; ++i) rw[i] = *reinterpret_cast<const u32x4*>(gW + (size_t)i * 32 * K + kt * 64);
#pragma unroll
  for (int i = 0; i < 2 * TM; ++i) ra[i] = *reinterpret_cast<const u32x4*>(gA + (size_t)i * 32 * K + kt * 64);
#pragma unroll
  for (int a = 0; a < 2; ++a)
#pragma unroll
    for (int b = 0; b < TM; ++b)
#pragma unroll
      for (int i = 0; i < 16; ++i) acc[a][b][i] = 0.f;
  char* sW = smem + (srow * 144 + skc * 16);
  char* sA = smem + ((128 + srow) * 144 + skc * 16);
  const char* fW = smem + ((wn * 64 + r) * 144 + h * 16);
  const char* fA = smem + ((128 + wm * (TM * 32) + r) * 144 + h * 16);
  for (int t = 0; t < T; ++t) {
    __syncthreads();
#pragma unroll
    for (int i = 0; i < 4; ++i) *reinterpret_cast<u32x4*>(sW + i * 32 * 144) = rw[i];
#pragma unroll
    for (int i = 0; i < 2 * TM; ++i) *reinterpret_cast<u32x4*>(sA + i * 32 * 144) = ra[i];
    __syncthreads();
    if (t + 1 < T) {
      kt = (kt + 1 == T) ? 0 : kt + 1;
#pragma unroll
      for (int i = 0; i < 4; ++i) rw[i] = *reinterpret_cast<const u32x4*>(gW + (size_t)i * 32 * K + kt * 64);
#pragma unroll
      for (int i = 0; i < 2 * TM; ++i) ra[i] = *reinterpret_cast<const u32x4*>(gA + (size_t)i * 32 * K + kt * 64);
    }
    {
      bf16x8 fa[2][2], fb[TM];
      fa[0][0] = ld8(fW); fa[0][1] = ld8(fW + 32 * 144);
#pragma unroll
      for (int tm = 0; tm < TM; ++tm) fb[tm] = ld8(fA + tm * 32 * 144);
      __builtin_amdgcn_s_setprio(1);
#pragma unroll
      for (int s = 0; s < 4; ++s) {
        const int cb = s & 1, nb = cb ^ 1;
        if (s < 3) { fa[nb][0] = ld8(fW + (s + 1) * 32); fa[nb][1] = ld8(fW + 32 * 144 + (s + 1) * 32); }
#pragma unroll
        for (int tm = 0; tm < TM; ++tm) {
          if (SWAP) {
            acc[0][tm] = MFMA(fb[tm], fa[cb][0], acc[0][tm]);
            acc[1][tm] = MFMA(fb[tm], fa[cb][1], acc[1][tm]);
          } else {
            acc[0][tm] = MFMA(fa[cb][0], fb[tm], acc[0][tm]);
            acc[1][tm] = MFMA(fa[cb][1], fb[tm], acc[1][tm]);
          }
          if (s < 3) fb[tm] = ld8(fA + tm * 32 * 144 + (s + 1) * 32);
        }
        if (s < 3) {
          __builtin_amdgcn_sched_group_barrier(0x100, 2, 0);
#pragma unroll
          for (int q = 0; q < TM; ++q) {
            __builtin_amdgcn_sched_group_barrier(0x008, 2, 0);
            __builtin_amdgcn_sched_group_barrier(0x100, 1, 0);
          }
        }
      }
      __builtin_amdgcn_s_setprio(0);
    }
  }
}

DI bool gemm_tile_of(int j, int NT, int MG, int& mt, int& nt) {
  const int xcd = obid() & 7;
  const int per = MG * NT;
  const int g = j / per, rem = j - g * per;
  nt = rem / MG;
  mt = (g * MG + (rem - nt * MG)) * 8 + xcd;
  return true;
}
DI void store_rm(u16* __restrict__ dst, int ld, int col0, int mw0, f32x16 (&acc)[2][4], float scale, int r, int h) {
#pragma unroll
  for (int tn = 0; tn < 2; ++tn)
#pragma unroll
    for (int tm = 0; tm < 4; ++tm) {
      size_t m = mw0 + tm * 32 + r;
#pragma unroll
      for (int g = 0; g < 4; ++g) {
        uint2 v;
        v.x = pack2(acc[tn][tm][4 * g] * scale, acc[tn][tm][4 * g + 1] * scale);
        v.y = pack2(acc[tn][tm][4 * g + 2] * scale, acc[tn][tm][4 * g + 3] * scale);
        *reinterpret_cast<uint2*>(dst + m * ld + col0 + tn * 32 + 8 * g + 4 * h) = v;
      }
      asm volatile("" ::: "memory");
    }
}
DI void store_tr(u16* __restrict__ dst, int tok0, f32x16 (&acc)[2][4], int r, int h) {
#pragma unroll
  for (int tn = 0; tn < 2; ++tn)
#pragma unroll
    for (int tm = 0; tm < 4; ++tm) {
      u16* bp = dst + (size_t)(tn * 32 + 4 * h) * TPB + tok0 + tm * 32 + r;
#pragma unroll
      for (int i = 0; i < 16; i += 2) {
        unsigned pk = pack2(acc[tn][tm][i], acc[tn][tm][i + 1]);
        bp[(size_t)((i & 3) + 8 * (i >> 2)) * TPB] = (u16)(pk & 0xffffu);
        bp[(size_t)(((i + 1) & 3) + 8 * ((i + 1) >> 2)) * TPB] = (u16)(pk >> 16);
      }
      asm volatile("" ::: "memory");
    }
}
DI void norm_rope_store(const P& p, const f32x16 (&acc)[2][4], const float* __restrict__ gw, bool isctx, int tokw0,
                        u16* __restrict__ dst, int ld, int col0, int mw0, float scale, int r, int h) {
#pragma unroll
  for (int tm = 0; tm < 4; ++tm) {
    float ss = 0.f;
#pragma unroll
    for (int tn = 0; tn < 2; ++tn)
#pragma unroll
      for (int i = 0; i < 16; ++i) ss += acc[tn][tm][i] * acc[tn][tm][i];
    ss += __shfl_xor(ss, 32);
    const float rs = rsqrtf(ss * (1.f / 64.f) + 1e-6f) * scale;
    const int tok = tokw0 + tm * 32 + r - 256;
    u16* drow = dst + (size_t)(mw0 + tm * 32 + r) * ld + col0 + 4 * h;
#pragma unroll
    for (int tn = 0; tn < 2; ++tn) {
      const int pos = isctx ? 0 : (tn == 0 ? (tok >> 6) : (tok & 63));
      const float* rp = pROPE + pos * 32 + 4 * h;
      const float* gp = gw + tn * 32 + 4 * h;
#pragma unroll
      for (int g = 0; g < 2; ++g) {
        const float4 c4 = *reinterpret_cast<const float4*>(rp + 8 * g);
        const float4 s4 = *reinterpret_cast<const float4*>(rp + 16 + 8 * g);
        const float4 ga = *reinterpret_cast<const float4*>(gp + 8 * g);
        const float4 gb = *reinterpret_cast<const float4*>(gp + 16 + 8 * g);
        const float cs[4] = {c4.x, c4.y, c4.z, c4.w}, sn[4] = {s4.x, s4.y, s4.z, s4.w};
        const float g1[4] = {ga.x, ga.y, ga.z, ga.w}, g2[4] = {gb.x, gb.y, gb.z, gb.w};
        float y1[4], y2[4];
#pragma unroll
        for (int j = 0; j < 4; ++j) {
          const int i = 4 * g + j;
          float x1 = acc[tn][tm][i] * rs * g1[j], x2 = acc[tn][tm][i + 8] * rs * g2[j];
          float c = isctx ? 1.f : cs[j], s = isctx ? 0.f : sn[j];
          y1[j] = x1 * c - x2 * s;
          y2[j] = x2 * c + x1 * s;
        }
        uint2 v1, v2;
        v1.x = pack2(y1[0], y1[1]); v1.y = pack2(y1[2], y1[3]);
        v2.x = pack2(y2[0], y2[1]); v2.y = pack2(y2[2], y2[3]);
        *reinterpret_cast<uint2*>(drow + tn * 32 + 8 * g) = v1;
        *reinterpret_cast<uint2*>(drow + tn * 32 + 8 * g + 16) = v2;
      }
    }
    asm volatile("" ::: "memory");
  }
}

DI void proj_phase(const P& p, int l, char* smem) {
  const int ntiles = 18 * 24;
  for (int it = obid() >> 3; it < ntiles; it += (gridDim.x >> 3)) {
    int nt, mt;
    gemm_tile_of(it, 24, 6, mt, nt);
    int n0 = nt * 128, m0 = mt * 256;
    bool isctx = (mt % 9) == 0;
    if (l == 3 && isctx && n0 >= 1792) continue;
    f32x16 acc[2][4];
    gemm_main<4>(pWinT, pH, 1024, n0, m0, mt * 3, smem, acc);
    const int tid = otid(), lane = tid & 63, w = tid >> 6, wn = w & 1, wm = w >> 1, r = lane & 31, h = lane >> 5;
    int nw = n0 + wn * 64;
    int mw0 = m0 + wm * 128;
    int b = m0 / TPB, tokw0 = mw0 - b * TPB;
    if (nw < 384) store_rm(pAK, 384, nw, mw0, acc, 1.f, r, h);
    else if (nw < 768) store_tr(pAVT + (size_t)(b * 6 + (nw - 384) / 64) * 64 * TPB, tokw0, acc, r, h);
    else if (nw < 896) norm_rope_store(p, acc, p.kn + l * 64, isctx, tokw0, pBKK, 128, nw - 768, mw0, 1.f, r, h);
    else if (nw < 1024) store_tr(pBVT + (size_t)(b * 2 + (nw - 896) / 64) * 64 * TPB, tokw0, acc, r, h);
    else if (nw < 1536) {
      const float* lbp = pLB + l * 512 + (nw - 1024);
#pragma unroll
      for (int tn = 0; tn < 2; ++tn)
#pragma unroll
        for (int tm = 0; tm < 4; ++tm) {
          size_t m = mw0 + tm * 32 + r;
#pragma unroll
          for (int g = 0; g < 4; ++g) {
            int cl = tn * 32 + 8 * g + 4 * h;
            float4 o;
            float* op = &o.x;
#pragma unroll
            for (int j = 0; j < 4; ++j) {
              float lb = lbp[cl + j], z = acc[tn][tm][4 * g + j];
              float sg = __builtin_amdgcn_rcpf(1.f + __expf(-z));
              op[j] = __logf(fmaxf(lb, 1e-30f) + (1.f - lb) * sg);
            }
            *reinterpret_cast<float4*>(pLOGF + m * 512 + (nw - 1024) + cl) = o;
          }
          asm volatile("" ::: "memory");
        }
    } else if (nw < 1792) store_rm(pCI, 256, nw - 1536, mw0, acc, 1.f, r, h);
    else if (nw < 2176) store_rm(pAQ, 384, nw - 1792, mw0, acc, 0.125f * LOG2E, r, h);
    else if (nw < 2560) norm_rope_store(p, acc, p.qn + l * 64, isctx, tokw0, pBQ, 384, nw - 2176, mw0, 0.125f * LOG2E, r, h);
    else if (nw < 2816) store_rm(pCQ, 256, nw - 2560, mw0, acc, 0.125f, r, h);
    else store_rm(pCG, 256, nw - 2816, mw0, acc, 1.f, r, h);
  }
}

DI void res_gemm_phase(const P& p, int l, const u16* Wt, const u16* A, int K, int gidx, char* smem) {
  const int ntiles = 24 * 8;
  for (int it = obid() >> 3; it < ntiles; it += (gridDim.x >> 3)) {
    int nt, mt;
    gemm_tile_of(it, 8, 1, mt, nt);
    int n0 = nt * 128, m0 = mt * 192;
    if (l == 3 && (m0 % TPB) == 0) continue;
    f32x16 acc[2][3];
    gemm_main<3>(Wt, A, K, n0, m0, mt * 3, smem, acc);
    const int tid = otid(), lane = tid & 63, w = tid >> 6, wn = w & 1, wm = w >> 1, r = lane & 31, h = lane >> 5;
    const bool ident = (gidx == 2 && l == 0);
    const float* lg = gidx == 2 ? p.ln2g + (l - 1) * 1024 : p.ln1g + l * 1024;
    const float* lb = gidx == 2 ? p.ln2b + (l - 1) * 1024 : p.ln1b + l * 1024;
#pragma unroll
    for (int tn = 0; tn < 2; ++tn)
#pragma unroll
      for (int tm = 0; tm < 3; ++tm) {
        const int m = m0 + wm * 96 + tm * 32 + r;
        const int b = m / TPB;
        const bool isctx = (m - b * TPB) < 256;
        const float* gp = pMOD + ((size_t)(l * 17 + (isctx ? 16 : b)) * 6 + gidx) * 1024;
        float* xr = xrow(p, m);
        const float2 st = *reinterpret_cast<const float2*>(pSTATS + 2 * (size_t)m);
#pragma unroll
        for (int g = 0; g < 4; ++g) {
          int n = n0 + wn * 64 + tn * 32 + 8 * g + 4 * h;
          float4 xv = *reinterpret_cast<float4*>(xr + n);
          if (!ident) {
            float4 G4 = *reinterpret_cast<const float4*>(lg + n);
            float4 B4 = *reinterpret_cast<const float4*>(lb + n);
            xv.x = (xv.x - st.x) * st.y * G4.x + B4.x;
            xv.y = (xv.y - st.x) * st.y * G4.y + B4.y;
            xv.z = (xv.z - st.x) * st.y * G4.z + B4.z;
            xv.w = (xv.w - st.x) * st.y * G4.w + B4.w;
          }
          float4 gv = *reinterpret_cast<const float4*>(gp + n);
          xv.x = ALPHA * xv.x + gv.x * acc[tn][tm][4 * g];
          xv.y = ALPHA * xv.y + gv.y * acc[tn][tm][4 * g + 1];
          xv.z = ALPHA * xv.z + gv.z * acc[tn][tm][4 * g + 2];
          xv.w = ALPHA * xv.w + gv.w * acc[tn][tm][4 * g + 3];
          *reinterpret_cast<float4*>(xr + n) = xv;
        }
      }
  }
}

DI void up_phase(const P& p, int l, char* smem) {
  const int ntiles = 18 * 44;
  float* ut = (float*)smem;
  for (int it = obid() >> 3; it < ntiles; it += (gridDim.x >> 3)) {
    int nt, mt;
    gemm_tile_of(it, 44, 6, mt, nt);
    int n0 = nt * 128, m0 = mt * 256;
    bool isctx = (mt % 9) == 0;
    if (l == 3 && isctx) continue;
    f32x16 acc[2][4];
    gemm_main<4, true>(pWupT, pH, 1024, n0, m0, mt * 3, smem, acc);
    const int tid = otid(), lane = tid & 63, w = tid >> 6, wn = w & 1, wm = w >> 1, r = lane & 31, h = lane >> 5;
    const float* cw = p.conv_w + (size_t)l * 3 * 5632;
    const float* cb = p.conv_b + (size_t)l * 5632;
    const int j = nt * 64 + wn * 32 + r;
    const float g0 = cw[j], g1 = cw[5632 + j], g2 = cw[2 * 5632 + j], gb = cb[j];
    const float v0 = cw[DFF + j], v1 = cw[5632 + DFF + j], v2 = cw[2 * 5632 + DFF + j], vb = cb[DFF + j];
    const int mt2 = mt * 2 + wm, mb = m0 + wm * 128;
    u16* arow = pACT + (size_t)mb * DFF + j;
    float* hrow = pHALO + (size_t)mt2 * 4 * 5632 + j;
    float P3g[4][4], P0g[4][4], P3v[4][4], P0v[4][4];
#pragma unroll
    for (int tm = 0; tm < 4; ++tm)
#pragma unroll
      for (int g = 0; g < 4; ++g) {
        P3g[tm][g] = __shfl_xor(acc[0][tm][4 * g + 3], 32); P0g[tm][g] = __shfl_xor(acc[0][tm][4 * g], 32);
        P3v[tm][g] = __shfl_xor(acc[1][tm][4 * g + 3], 32); P0v[tm][g] = __shfl_xor(acc[1][tm][4 * g], 32);
      }
#pragma unroll
    for (int tm = 0; tm < 4; ++tm)
#pragma unroll
      for (int g = 0; g < 4; ++g) {
        const float lo_g = (g > 0) ? P3g[tm][g > 0 ? g - 1 : 0] : (tm > 0 ? P3g[tm > 0 ? tm - 1 : 0][3] : 0.f);
        const float lo_v = (g > 0) ? P3v[tm][g > 0 ? g - 1 : 0] : (tm > 0 ? P3v[tm > 0 ? tm - 1 : 0][3] : 0.f);
        const float pgE = h ? P3g[tm][g] : lo_g, pvE = h ? P3v[tm][g] : lo_v;
        const float hi_g = (g < 3) ? P0g[tm][g < 3 ? g + 1 : 3] : (tm < 3 ? P0g[tm < 3 ? tm + 1 : 3][0] : 0.f);
        const float hi_v = (g < 3) ? P0v[tm][g < 3 ? g + 1 : 3] : (tm < 3 ? P0v[tm < 3 ? tm + 1 : 3][0] : 0.f);
        const float ngE = h ? hi_g : P0g[tm][g], nvE = h ? hi_v : P0v[tm][g];
#pragma unroll
        for (int k = 0; k < 4; ++k) {
          const int i = 4 * g + k;
          const float pg = k > 0 ? acc[0][tm][k > 0 ? i - 1 : i] : pgE, ng = k < 3 ? acc[0][tm][k < 3 ? i + 1 : i] : ngE;
          const float pv = k > 0 ? acc[1][tm][k > 0 ? i - 1 : i] : pvE, nv = k < 3 ? acc[1][tm][k < 3 ? i + 1 : i] : nvE;
          const float gate = g0 * pg + g1 * acc[0][tm][i] + g2 * ng + gb;
          const float val = v0 * pv + v1 * acc[1][tm][i] + v2 * nv + vb;
          const int t = tm * 32 + 8 * g + 4 * h + k;
          if (!((tm == 0 && g == 0 && k == 0 && h == 0) || (tm == 3 && g == 3 && k == 3 && h == 1)))
            arow[(size_t)t * DFF] = (u16)f2bf(siluf(gate) * val);
        }
      }
    if (h == 0) {
      hrow[0] = acc[0][0][0]; hrow[DFF] = acc[1][0][0];
      hrow[5632] = acc[0][0][1]; hrow[5632 + DFF] = acc[1][0][1];
    } else {
      hrow[2 * 5632] = acc[0][3][14]; hrow[2 * 5632 + DFF] = acc[1][3][14];
      hrow[3 * 5632] = acc[0][3][15]; hrow[3 * 5632 + DFF] = acc[1][3][15];
    }
  }
}

DI void fixup_phase(const P& p, int l) {
  const int total = 288 * DFF;
  const float* cw = p.conv_w + (size_t)l * 3 * 5632;
  const float* cb = p.conv_b + (size_t)l * 5632;
  for (int idx = obid() * 256 + otid(); idx < total; idx += gridDim.x * 256) {
    int mt = idx / DFF, j = idx - mt * DFF;
    int tb = mt % 18;
    bool isctx = tb < 2;
    if (l == 3 && isctx) continue;
    bool segstart = (tb == 0) || (tb == 2), segend = (tb == 1) || (tb == 17);
    const float* hm = pHALO + (size_t)mt * 4 * 5632;
    float g0 = cw[j], g1 = cw[5632 + j], g2 = cw[2 * 5632 + j], gb = cb[j];
    float v0 = cw[DFF + j], v1 = cw[5632 + DFF + j], v2 = cw[2 * 5632 + DFF + j], vb = cb[DFF + j];
    {
      float pg = segstart ? 0.f : hm[-5632 + j], pv = segstart ? 0.f : hm[-5632 + DFF + j];
      float gate = g0 * pg + g1 * hm[j] + g2 * hm[5632 + j] + gb;
      float val = v0 * pv + v1 * hm[DFF + j] + v2 * hm[5632 + DFF + j] + vb;
      pACT[(size_t)(mt * 128) * DFF + j] = (u16)f2bf(siluf(gate) * val);
    }
    {
      float ng = segend ? 0.f : hm[4 * 5632 + j], nv = segend ? 0.f : hm[4 * 5632 + DFF + j];
      float gate = g0 * hm[2 * 5632 + j] + g1 * hm[3 * 5632 + j] + g2 * ng + gb;
      float val = v0 * hm[2 * 5632 + DFF + j] + v1 * hm[3 * 5632 + DFF + j] + v2 * nv + vb;
      pACT[(size_t)(mt * 128 + 127) * DFF + j] = (u16)f2bf(siluf(gate) * val);
    }
  }
}

DI void ln_phase(const P& p, int mode, int l) {
  const int lane = otid() & 63;
  const int gw = obid() * 4 + (otid() >> 6), nw = gridDim.x * 4;
  const bool latonly = (mode != 0 && l == 3);
  const int nrows = latonly ? 16 * 2048 : MTOK;
  const bool final_ = (mode == 2 && l == 3);
  auto row_of = [&](int idx) { return latonly ? (idx >> 11) * TPB + 256 + (idx & 2047) : idx; };
  auto src_of = [&](int row) -> const float* {
    int b = row / TPB, i = row - b * TPB;
    if (mode == 0) return i < 256 ? p.ctx + ((size_t)(b * 256 + i) << 10) : p.x + ((size_t)(b * 2048 + i - 256) << 10);
    return xrow(p, row);
  };
  float4 nx[4];
  if (gw < nrows) {
    const float* s0 = src_of(row_of(gw));
#pragma unroll
    for (int q = 0; q < 4; ++q) nx[q] = *reinterpret_cast<const float4*>(s0 + q * 256 + lane * 4);
  }
  for (int idx = gw; idx < nrows; idx += nw) {
    const int row = row_of(idx);
    const int b = row / TPB, i = row - b * TPB;
    const bool isctx = i < 256;
    float v[16];
#pragma unroll
    for (int q = 0; q < 4; ++q) { v[4 * q] = nx[q].x; v[4 * q + 1] = nx[q].y; v[4 * q + 2] = nx[q].z; v[4 * q + 3] = nx[q].w; }
    if (idx + nw < nrows) {
      const float* s1 = src_of(row_of(idx + nw));
#pragma unroll
      for (int q = 0; q < 4; ++q) nx[q] = *reinterpret_cast<const float4*>(s1 + q * 256 + lane * 4);
    }
    if (mode != 0) {
      float s = 0.f;
#pragma unroll
      for (int q = 0; q < 16; ++q) s += v[q];
      float mu = wave_sum(s) * (1.f / 1024.f);
      float s2 = 0.f;
#pragma unroll
      for (int q = 0; q < 16; ++q) { v[q] -= mu; s2 += v[q] * v[q]; }
      float rs = rsqrtf(wave_sum(s2) * (1.f / 1024.f) + 1e-6f);
      if (!final_ && lane == 0) { float2 st = {mu, rs}; *reinterpret_cast<float2*>(pSTATS + 2 * (size_t)row) = st; }
      const float* gg = (mode == 1 ? p.ln1g : p.ln2g) + l * 1024;
      const float* bb = (mode == 1 ? p.ln1b : p.ln2b) + l * 1024;
#pragma unroll
      for (int q = 0; q < 4; ++q) {
        float4 g4 = *reinterpret_cast<const float4*>(gg + q * 256 + lane * 4);
        float4 b4 = *reinterpret_cast<const float4*>(bb + q * 256 + lane * 4);
        v[4 * q] = v[4 * q] * rs * g4.x + b4.x;
        v[4 * q + 1] = v[4 * q + 1] * rs * g4.y + b4.y;
        v[4 * q + 2] = v[4 * q + 2] * rs * g4.z + b4.z;
        v[4 * q + 3] = v[4 * q + 3] * rs * g4.w + b4.w;
      }
    } else if (lane == 0) {
      float2 st = {0.f, 1.f};
      *reinterpret_cast<float2*>(pSTATS + 2 * (size_t)row) = st;
    }
    if (mode == 0 || final_) {
      float* dst = xrow(p, row);
#if SELFCHECK
      if (final_) {
        float bump = (float)(*((volatile unsigned*)(p.ws + O_FLAG)));
#pragma unroll
        for (int q = 0; q < 16; ++q) v[q] += bump;
      }
#endif
#pragma unroll
      for (int q = 0; q < 4; ++q) {
        float4 t = {v[4 * q], v[4 * q + 1], v[4 * q + 2], v[4 * q + 3]};
        *reinterpret_cast<float4*>(dst + q * 256 + lane * 4) = t;
      }
    }
    if (final_) continue;
    {
      float s = 0.f;
#pragma unroll
      for (int q = 0; q < 16; ++q) s += v[q];
      float mu = wave_sum(s) * (1.f / 1024.f);
      float s2 = 0.f;
#pragma unroll
      for (int q = 0; q < 16; ++q) { v[q] -= mu; s2 += v[q] * v[q]; }
      float rs = rsqrtf(wave_sum(s2) * (1.f / 1024.f) + 1e-6f);
      int ml = mode == 2 ? l + 1 : (mode == 0 ? 0 : l);
      int sidx = mode == 1 ? 3 : 0;
      const float* sh = pMOD + ((size_t)(ml * 17 + (isctx ? 16 : b)) * 6 + sidx) * 1024;
      const float* sc = sh + 1024;
#pragma unroll
      for (int q = 0; q < 4; ++q) {
        float4 s4 = *reinterpret_cast<const float4*>(sh + q * 256 + lane * 4);
        float4 c4 = *reinterpret_cast<const float4*>(sc + q * 256 + lane * 4);
        uint2 o;
        o.x = pack2(v[4 * q] * rs * (1.f + c4.x) + s4.x, v[4 * q + 1] * rs * (1.f + c4.y) + s4.y);
        o.y = pack2(v[4 * q + 2] * rs * (1.f + c4.z) + s4.z, v[4 * q + 3] * rs * (1.f + c4.w) + s4.w);
        *reinterpret_cast<uint2*>(pH + (size_t)row * 1024 + q * 256 + lane * 4) = o;
      }
    }
  }
}

template <bool FIXM>
DI void attn_block(const u16* __restrict__ Qp, int ldq, const u16* __restrict__ Kp, int ldk, const u16* __restrict__ Vt, int NT,
                   bool na, int rs_min, int rstart_w, int qr, int q0, const float* __restrict__ rpbh, u16* __restrict__ Op,
                   char* smem, float sshift = 0.f) {
  const int tid = otid(), lane = tid & 63, r = lane & 31, h = lane >> 5;
  bf16x8 qf[4];
#pragma unroll
  for (int s = 0; s < 4; ++s) qf[s] = ld8(Qp + (size_t)r * ldq + 16 * s + 8 * h);
  f32x16 o0, o1;
#pragma unroll
  for (int i = 0; i < 16; ++i) { o0[i] = 0.f; o1[i] = 0.f; }
  float mrun = -1e30f, lrun = 0.f;
  f32x16 lacc;
#pragma unroll
  for (int i = 0; i < 16; ++i) lacc[i] = 0.f;
  const bf16x8 ones8 = mk8(0x3F803F80u, 0x3F803F80u, 0x3F803F80u, 0x3F803F80u);
  const int lrow = tid >> 3, lkc = tid & 7;
  u32x4 rk[2], rv[2];
  char* sst = smem + lrow * 144 + lkc * 16;
#define ATT_KTOK(t) (na ? ((t) < 4 ? 64 * (t) : 256 + (rs_min + (t) - 4) * 64) : 64 * (t))
#define ATT_LOAD(t) do { const int kt_ = ATT_KTOK(t); \
    rk[0] = *reinterpret_cast<const u32x4*>(Kp + (size_t)(kt_ + lrow) * ldk + lkc * 8); \
    rk[1] = *reinterpret_cast<const u32x4*>(Kp + (size_t)(kt_ + lrow + 32) * ldk + lkc * 8); \
    rv[0] = *reinterpret_cast<const u32x4*>(Vt + (size_t)lrow * TPB + kt_ + lkc * 8); \
    rv[1] = *reinterpret_cast<const u32x4*>(Vt + (size_t)(lrow + 32) * TPB + kt_ + lkc * 8); } while (0)
#define ATT_STORE(bf) do { char* d_ = sst + (bf) * 18432; \
    *reinterpret_cast<u32x4*>(d_) = rk[0]; *reinterpret_cast<u32x4*>(d_ + 32 * 144) = rk[1]; \
    *reinterpret_cast<u32x4*>(d_ + 9216) = rv[0]; *reinterpret_cast<u32x4*>(d_ + 9216 + 32 * 144) = rv[1]; } while (0)
  __syncthreads();
  float* lrpb = (float*)(smem + 36864);
  if (na) {
    for (int idx = tid; idx < 465; idx += 256) lrpb[idx] = rpbh[idx];
  }
  ATT_LOAD(0);
  ATT_STORE(0);
  __syncthreads();
  for (int t = 0; t < NT; ++t) {
    if (t + 1 < NT) ATT_LOAD(t + 1);
    const int kr = rs_min + t - 4;
    const bool rowtile = na && t >= 4;
    const bool active = !rowtile || (kr >= rstart_w && kr < rstart_w + 8);
    if (active) {
      const char* kb = smem + (t & 1) * 18432 + r * 144 + h * 16;
      const char* vb = smem + (t & 1) * 18432 + 9216 + r * 144 + h * 8;
      f32x16 S0, S1;
      const float sinit = FIXM ? -sshift : 0.f;
#pragma unroll
      for (int i = 0; i < 16; ++i) { S0[i] = sinit; S1[i] = sinit; }
      {
        bf16x8 kf[8];
#pragma unroll
        for (int s = 0; s < 4; ++s) { kf[s] = ld8(kb + s * 32); kf[4 + s] = ld8(kb + 32 * 144 + s * 32); }
#pragma unroll
        for (int s = 0; s < 4; ++s) S0 = MFMA(kf[s], qf[s], S0);
#pragma unroll
        for (int s = 0; s < 4; ++s) S1 = MFMA(kf[4 + s], qf[s], S1);
      }
      bf16x8 vf[8];
#pragma unroll
      for (int kq = 0; kq < 4; ++kq) {
        uint2 a0 = *reinterpret_cast<const uint2*>(vb + kq * 32), a1 = *reinterpret_cast<const uint2*>(vb + kq * 32 + 16);
        uint2 b0 = *reinterpret_cast<const uint2*>(vb + 32 * 144 + kq * 32), b1 = *reinterpret_cast<const uint2*>(vb + 32 * 144 + kq * 32 + 16);
        vf[kq] = mk8(a0.x, a0.y, a1.x, a1.y);
        vf[4 + kq] = mk8(b0.x, b0.y, b1.x, b1.y);
      }
      if (FIXM) {
#pragma unroll
        for (int i = 0; i < 16; ++i) S0[i] = ex2(S0[i]);
        bf16x8 pa0 = mk8(pack2(S0[0], S0[1]), pack2(S0[2], S0[3]), pack2(S0[4], S0[5]), pack2(S0[6], S0[7]));
        bf16x8 pa1 = mk8(pack2(S0[8], S0[9]), pack2(S0[10], S0[11]), pack2(S0[12], S0[13]), pack2(S0[14], S0[15]));
        o0 = MFMA(vf[0], pa0, o0);
        o1 = MFMA(vf[4], pa0, o1);
        lacc = MFMA(ones8, pa0, lacc);
        o0 = MFMA(vf[1], pa1, o0);
        o1 = MFMA(vf[5], pa1, o1);
        lacc = MFMA(ones8, pa1, lacc);
        __builtin_amdgcn_sched_barrier(0);
#pragma unroll
        for (int i = 0; i < 16; ++i) S1[i] = ex2(S1[i]);
        bf16x8 pa2 = mk8(pack2(S1[0], S1[1]), pack2(S1[2], S1[3]), pack2(S1[4], S1[5]), pack2(S1[6], S1[7]));
        bf16x8 pa3 = mk8(pack2(S1[8], S1[9]), pack2(S1[10], S1[11]), pack2(S1[12], S1[13]), pack2(S1[14], S1[15]));
        o0 = MFMA(vf[2], pa2, o0);
        o1 = MFMA(vf[6], pa2, o1);
        lacc = MFMA(ones8, pa2, lacc);
        o0 = MFMA(vf[3], pa3, o0);
        o1 = MFMA(vf[7], pa3, o1);
        lacc = MFMA(ones8, pa3, lacc);
      } else {
        auto softmax_pv = [&](auto mode_tag) {
          constexpr int MODE = decltype(mode_tag)::value;
          if (MODE != 0) {
            const int wq = q0 + r;
            const int cs = min(max(wq - 8, 0), 48);
            const float* bp = lrpb + (kr - qr + 7) * 31 + 15 - wq;
#pragma unroll
            for (int i = 0; i < 16; ++i) {
              const int kc = crow(i, h);
              if (!(MODE == 2 && i < 12)) {
                bool ok = (kc >= cs) && (kc < cs + 16);
                float bias = bp[ok ? kc : cs] * LOG2E;
                S0[i] = ok ? S0[i] + bias : -1e30f;
              }
              if (!(MODE == 1 && i >= 4)) {
                const int kc2 = kc + 32;
                bool ok2 = (kc2 >= cs) && (kc2 < cs + 16);
                float bias2 = bp[ok2 ? kc2 : cs] * LOG2E;
                S1[i] = ok2 ? S1[i] + bias2 : -1e30f;
              }
            }
          }
          float tmax = -1e30f;
#pragma unroll
          for (int i = 0; i < 16; ++i) {
            if (!(MODE == 2 && i < 12)) tmax = fmaxf(tmax, S0[i]);
            if (!(MODE == 1 && i >= 4)) tmax = fmaxf(tmax, S1[i]);
          }
          tmax = fmaxf(tmax, __shfl_xor(tmax, 32));
          const float mnew = fmaxf(mrun, tmax);
          const float alpha = ex2(mrun - mnew);
          mrun = mnew;
          float ps = 0.f;
#pragma unroll
          for (int i = 0; i < 16; ++i) {
            if (!(MODE == 2 && i < 12)) { S0[i] = ex2(S0[i] - mnew); ps += S0[i]; } else S0[i] = 0.f;
            if (!(MODE == 1 && i >= 4)) { S1[i] = ex2(S1[i] - mnew); ps += S1[i]; } else S1[i] = 0.f;
          }
          lrun = lrun * alpha + ps;
#pragma unroll
          for (int i = 0; i < 16; ++i) { o0[i] *= alpha; o1[i] *= alpha; }
          bf16x8 pb[4];
          pb[0] = mk8(pack2(S0[0], S0[1]), pack2(S0[2], S0[3]), pack2(S0[4], S0[5]), pack2(S0[6], S0[7]));
          pb[1] = mk8(pack2(S0[8], S0[9]), pack2(S0[10], S0[11]), pack2(S0[12], S0[13]), pack2(S0[14], S0[15]));
          pb[2] = mk8(pack2(S1[0], S1[1]), pack2(S1[2], S1[3]), pack2(S1[4], S1[5]), pack2(S1[6], S1[7]));
          pb[3] = mk8(pack2(S1[8], S1[9]), pack2(S1[10], S1[11]), pack2(S1[12], S1[13]), pack2(S1[14], S1[15]));
#pragma unroll
          for (int kq = 0; kq < 4; ++kq) {
            if ((MODE == 2 && kq == 0) || (MODE == 1 && kq == 3)) continue;
            o0 = MFMA(vf[kq], pb[kq], o0);
            o1 = MFMA(vf[4 + kq], pb[kq], o1);
          }
        };
        if (!rowtile) softmax_pv(std::integral_constant<int, 0>{});
        else if (q0 == 0) softmax_pv(std::integral_constant<int, 1>{});
        else softmax_pv(std::integral_constant<int, 2>{});
      }
    }
    if (t + 1 < NT) ATT_STORE((t + 1) & 1);
    __syncthreads();
  }
#undef ATT_KTOK
#undef ATT_LOAD
#undef ATT_STORE
  float inv = FIXM ? 1.f / lacc[0] : 1.f / (lrun + __shfl_xor(lrun, 32));
  u16* op = Op + (size_t)r * 1024 + 4 * h;
#pragma unroll
  for (int g = 0; g < 4; ++g) {
    uint2 a, b;
    a.x = pack2(o0[4 * g] * inv, o0[4 * g + 1] * inv);
    a.y = pack2(o0[4 * g + 2] * inv, o0[4 * g + 3] * inv);
    b.x = pack2(o1[4 * g] * inv, o1[4 * g + 1] * inv);
    b.y = pack2(o1[4 * g + 2] * inv, o1[4 * g + 3] * inv);
    *reinterpret_cast<uint2*>(op + 8 * g) = a;
    *reinterpret_cast<uint2*>(op + 32 + 8 * g) = b;
  }
}

DI int seq_idx(int dir, int pos) { return dir == 0 ? pos : (pos < 4 ? 3 - pos : 39 - pos); }

DI void h1_item(const P& p, int b, int head, int pos, char* smem) {
  const int tid = otid(), lane = tid & 63, w = tid >> 6, r = lane & 31, h = lane >> 5;
  char* kdT = smem;
  char* vT = smem + 2 * 9216;
  const size_t row0 = (size_t)b * TPB + pos * 64;
  if (w < 2) {
    const int dir = w, ch = lane;
    const float* lp = pLOGF + row0 * 512 + dir * 256 + head * 64 + ch;
    float lfv[64];
#pragma unroll
    for (int j = 0; j < 64; ++j) lfv[j] = lp[(size_t)j * 512];
    float sfx = 0.f;
    if (dir == 0) {
#pragma unroll
      for (int gq = 7; gq >= 0; --gq) {
        float kd[8];
#pragma unroll
        for (int j = 7; j >= 0; --j) {
          float lf = lfv[gq * 8 + j];
          kd[j] = (1.f - __expf(lf)) * __expf(sfx);
          sfx += lf;
        }
        u32x4 o = {pack2(kd[0], kd[1]), pack2(kd[2], kd[3]), pack2(kd[4], kd[5]), pack2(kd[6], kd[7])};
        *reinterpret_cast<u32x4*>(kdT + ch * 144 + gq * 16) = o;
      }
    } else {
#pragma unroll
      for (int gq = 0; gq < 8; ++gq) {
        float kd[8];
#pragma unroll
        for (int j = 0; j < 8; ++j) {
          float lf = lfv[gq * 8 + j];
          kd[j] = (1.f - __expf(lf)) * __expf(sfx);
          sfx += lf;
        }
        u32x4 o = {pack2(kd[0], kd[1]), pack2(kd[2], kd[3]), pack2(kd[4], kd[5]), pack2(kd[6], kd[7])};
        *reinterpret_cast<u32x4*>(kdT + 9216 + ch * 144 + gq * 16) = o;
      }
    }
    int chain = (b * 4 + head) * 2 + dir;
    pDST[((size_t)chain * 36 + seq_idx(dir, pos)) * 64 + ch] = sfx;
  } else {
    const int dv = lane, half = w - 2;
    const u16* vp = pCI + (row0 + half * 32) * 256 + head * 64 + dv;
    unsigned vv[32];
#pragma unroll
    for (int j = 0; j < 32; ++j) vv[j] = vp[(size_t)j * 256];
#pragma unroll
    for (int gi = 0; gi < 4; ++gi) {
      u32x4 o = {vv[8 * gi] | (vv[8 * gi + 1] << 16), vv[8 * gi + 2] | (vv[8 * gi + 3] << 16), vv[8 * gi + 4] | (vv[8 * gi + 5] << 16),
                 vv[8 * gi + 6] | (vv[8 * gi + 7] << 16)};
      *reinterpret_cast<u32x4*>(vT + dv * 144 + (half * 4 + gi) * 16) = o;
    }
  }
  __syncthreads();
  {
    const int dir = w & 1, dvh = w >> 1;
    int chain = (b * 4 + head) * 2 + dir;
    float* up = pUST + ((size_t)chain * 36 + seq_idx(dir, pos)) * 4096;
#pragma unroll
    for (int tc = 0; tc < 2; ++tc) {
      f32x16 acc;
#pragma unroll
      for (int i = 0; i < 16; ++i) acc[i] = 0.f;
#pragma unroll
      for (int ks = 0; ks < 4; ++ks) {
        bf16x8 a = ld8(kdT + dir * 9216 + (tc * 32 + r) * 144 + (16 * ks + 8 * h) * 2);
        bf16x8 bb = ld8(vT + (dvh * 32 + r) * 144 + (16 * ks + 8 * h) * 2);
        acc = MFMA(a, bb, acc);
      }
#pragma unroll
      for (int g = 0; g < 4; ++g) {
        float4 v4 = {acc[4 * g], acc[4 * g + 1], acc[4 * g + 2], acc[4 * g + 3]};
        *reinterpret_cast<float4*>(up + (dvh * 32 + r) * 64 + tc * 32 + 8 * g + 4 * h) = v4;
      }
    }
  }
  __syncthreads();
}

DI void h2_phase(const P& p) {
  const int total = 128 * 4096;
  for (int idx = obid() * 256 + otid(); idx < total; idx += gridDim.x * 256) {
    int chain = idx >> 12, e = idx & 4095, ch = e & 63;
    const float* up = pUST + (size_t)chain * 36 * 4096 + e;
    const float* dp = pDST + (size_t)chain * 36 * 64 + ch;
    u16* sp = pSTT + (size_t)chain * 36 * 4096 + e;
    float S = 0.f;
#pragma unroll
    for (int n = 0; n < 36; ++n) {
      sp[(size_t)n * 4096] = (u16)f2bf(S);
      S = S * __expf(dp[n * 64]) + up[(size_t)n * 4096];
    }
  }
}

DI void h3_item(const P& p, int l, int b, int head, int pos, char* smem) {
  const int tid = otid(), lane = tid & 63, w = tid >> 6, r = lane & 31, h = lane >> 5;
  char* kS = smem;
  char* qS = smem + 9216;
  char* qeS = smem + 2 * 9216;
  char* vT = smem + 3 * 9216;
  float* tot = (float*)(smem + 4 * 9216);
  float* ssq = tot + 256;
  const size_t row0 = (size_t)b * TPB + pos * 64;
  const int tdv = w & 1, tt = w >> 1;
  float lfA[2][16];
  unsigned qA[16];
  bf16x8 stfA[2][4];
  uint2 gvA[4];
  {
    const float* lp_ = pLOGF + (row0 + w * 16) * 512 + head * 64 + lane;
    const u16* qp_ = pCQ + (row0 + w * 16) * 256 + head * 64 + lane;
#pragma unroll
    for (int j = 0; j < 16; ++j) { lfA[0][j] = lp_[(size_t)j * 512]; lfA[1][j] = lp_[(size_t)j * 512 + 256]; qA[j] = qp_[(size_t)j * 256]; }
#pragma unroll
    for (int d = 0; d < 2; ++d) {
      const u16* stp_ = pSTT + ((size_t)((b * 4 + head) * 2 + d) * 36 + seq_idx(d, pos)) * 4096;
#pragma unroll
      for (int ks = 0; ks < 4; ++ks) stfA[d][ks] = ld8(stp_ + (tdv * 32 + r) * 64 + 16 * ks + 8 * h);
    }
#pragma unroll
    for (int g = 0; g < 4; ++g)
      gvA[g] = *reinterpret_cast<const uint2*>(pCG + (row0 + tt * 32 + r) * 256 + head * 64 + tdv * 32 + 8 * g + 4 * h);
  }
  {
    const int dv = lane, seg = w;
    const u16* vp = pCI + (row0 + seg * 16) * 256 + head * 64 + dv;
    unsigned vv[16];
#pragma unroll
    for (int j = 0; j < 16; ++j) vv[j] = vp[(size_t)j * 256];
    u32x4 o0 = {vv[0] | (vv[1] << 16), vv[2] | (vv[3] << 16), vv[4] | (vv[5] << 16), vv[6] | (vv[7] << 16)};
    u32x4 o1 = {vv[8] | (vv[9] << 16), vv[10] | (vv[11] << 16), vv[12] | (vv[13] << 16), vv[14] | (vv[15] << 16)};
    *reinterpret_cast<u32x4*>(vT + dv * 144 + seg * 32) = o0;
    *reinterpret_cast<u32x4*>(vT + dv * 144 + seg * 32 + 16) = o1;
  }
  f32x16 o;
#pragma unroll
  for (int i = 0; i < 16; ++i) o[i] = 0.f;
#pragma unroll
  for (int dir = 0; dir < 2; ++dir) {
    const int ch = lane, seg = w;
    float lf[16], cs[16];
#pragma unroll
    for (int j = 0; j < 16; ++j) lf[j] = lfA[dir][j];
    float run = 0.f;
    if (dir == 0) {
#pragma unroll
      for (int j = 0; j < 16; ++j) { run += lf[j]; cs[j] = run; }
    } else {
#pragma unroll
      for (int j = 15; j >= 0; --j) { run += lf[j]; cs[j] = run; }
    }
    tot[seg * 64 + ch] = run;
    __syncthreads();
    float t0 = tot[ch], t1 = tot[64 + ch], t2 = tot[128 + ch], t3 = tot[192 + ch];
    float off, bref;
    if (dir == 0) { off = (seg > 0 ? t0 : 0.f) + (seg > 1 ? t1 : 0.f) + (seg > 2 ? t2 : 0.f); bref = t0 + t1; }
    else { off = (seg < 3 ? t3 : 0.f) + (seg < 2 ? t2 : 0.f) + (seg < 1 ? t1 : 0.f); bref = t3 + t2; }
    const float ebref = __expf(bref);
#pragma unroll
    for (int j = 0; j < 16; ++j) {
      float bb = cs[j] + off;
      float q = bf2f((u16)qA[j]);
      float k = 1.f - __expf(lf[j]);
      int rho = seg * 16 + j;
      const float e1 = __expf(fminf(fmaxf(bb - bref, -80.f), 80.f)), qt = q * e1;
      *reinterpret_cast<u16*>(kS + rho * 144 + ch * 2) = (u16)f2bf(k * __builtin_amdgcn_rcpf(e1));
      *reinterpret_cast<u16*>(qS + rho * 144 + ch * 2) = (u16)f2bf(qt);
      *reinterpret_cast<u16*>(qeS + rho * 144 + ch * 2) = (u16)f2bf(qt * ebref);
    }
    __syncthreads();
#pragma unroll
    for (int ts = 0; ts < 2; ++ts) {
      f32x16 S;
#pragma unroll
      for (int i = 0; i < 16; ++i) S[i] = 0.f;
#pragma unroll
      for (int ks = 0; ks < 4; ++ks) {
        bf16x8 a = ld8(kS + (ts * 32 + r) * 144 + (16 * ks + 8 * h) * 2);
        bf16x8 bq = ld8(qS + (tt * 32 + r) * 144 + (16 * ks + 8 * h) * 2);
        S = MFMA(a, bq, S);
      }
      int tau = tt * 32 + r;
#pragma unroll
      for (int i = 0; i < 16; ++i) {
        int s = ts * 32 + crow(i, h);
        bool keep = dir == 0 ? (s <= tau) : (s >= tau);
        S[i] = keep ? S[i] : 0.f;
      }
      bf16x8 pb0 = mk8(pack2(S[0], S[1]), pack2(S[2], S[3]), pack2(S[4], S[5]), pack2(S[6], S[7]));
      bf16x8 pb1 = mk8(pack2(S[8], S[9]), pack2(S[10], S[11]), pack2(S[12], S[13]), pack2(S[14], S[15]));
      const char* vb = vT + (tdv * 32 + r) * 144 + (ts * 32 + 4 * h) * 2;
      uint2 a0 = *reinterpret_cast<const uint2*>(vb), a1 = *reinterpret_cast<const uint2*>(vb + 16);
      uint2 a2 = *reinterpret_cast<const uint2*>(vb + 32), a3 = *reinterpret_cast<const uint2*>(vb + 48);
      o = MFMA(mk8(a0.x, a0.y, a1.x, a1.y), pb0, o);
      o = MFMA(mk8(a2.x, a2.y, a3.x, a3.y), pb1, o);
    }
#pragma unroll
    for (int ks = 0; ks < 4; ++ks) {
      bf16x8 bq = ld8(qeS + (tt * 32 + r) * 144 + (16 * ks + 8 * h) * 2);
      o = MFMA(stfA[dir][ks], bq, o);
    }
    __syncthreads();
  }
  float ss = 0.f;
#pragma unroll
  for (int i = 0; i < 16; ++i) ss += o[i] * o[i];
  ss += __shfl_xor(ss, 32);
  if (h == 0) ssq[tdv * 64 + tt * 32 + r] = ss;
  __syncthreads();
  float tot2 = ssq[tt * 32 + r] + ssq[64 + tt * 32 + r];
  float rs = rsqrtf(tot2 * (1.f / 64.f) + 1e-6f);
  const size_t row = row0 + tt * 32 + r;
  const float* gn = p.hgn + l * 64;
#pragma unroll
  for (int g = 0; g < 4; ++g) {
    int dv = tdv * 32 + 8 * g + 4 * h;
    uint2 gv = gvA[g];
    float g0 = bf2f((u16)(gv.x & 0xffff)), g1 = bf2f((u16)(gv.x >> 16)), g2 = bf2f((u16)(gv.y & 0xffff)), g3 = bf2f((u16)(gv.y >> 16));
    uint2 ov;
    ov.x = pack2(o[4 * g] * rs * gn[dv] * siluf(g0), o[4 * g + 1] * rs * gn[dv + 1] * siluf(g1));
    ov.y = pack2(o[4 * g + 2] * rs * gn[dv + 2] * siluf(g2), o[4 * g + 3] * rs * gn[dv + 3] * siluf(g3));
    *reinterpret_cast<uint2*>(pMIX + row * 1024 + 768 + head * 64 + dv) = ov;
  }
  __syncthreads();
}

DI void attn_phase(const P& p, int l, char* smem) {
  const int tid = otid(), lane = tid & 63, w = tid >> 6;
  const int n_gl = 1536, n_nl = 1536, n_gc = (l == 3) ? 0 : 192, n_nc = (l == 3) ? 0 : 192, n_h1 = 2304;
  const int total = n_gl + n_nl + n_gc + n_nc + n_h1;
  for (int it = obid(); it < total; it += gridDim.x) {
    int i = it;
    if (i < n_gl) {
      int b = i / 96, rem = i % 96, hq = rem / 16, qb = rem % 16, kvh = hq / 3;
      size_t qrow = (size_t)b * TPB + 256 + qb * 128 + w * 32;
      attn_block<true>(pBQ + qrow * 384 + hq * 64, 384, pBKK + (size_t)b * TPB * 128 + kvh * 64, 128,
                 pBVT + (size_t)(b * 2 + kvh) * 64 * TPB, 36, false, 0, 0, 0, 0, nullptr, pMIX + qrow * 1024 + 384 + hq * 64, smem, pMISC[l]);
      continue;
    }
    i -= n_gl;
    if (i < n_nl) {
      int b = i / 96, rem = i % 96, hh = rem / 16, rp = rem % 16;
      int qr = rp * 2 + (w >> 1), q0 = (w & 1) * 32;
      int rstart = min(max(qr - 4, 0), 24);
      int rs_min = min(max(rp * 2 - 4, 0), 24), rs_max = min(max(rp * 2 + 1 - 4, 0), 24);
      size_t qrow = (size_t)b * TPB + 256 + qr * 64 + q0;
      attn_block<false>(pAQ + qrow * 384 + hh * 64, 384, pAK + (size_t)b * TPB * 384 + hh * 64, 384,
                 pAVT + (size_t)(b * 6 + hh) * 64 * TPB, 4 + rs_max + 8 - rs_min, true, rs_min, rstart, qr, q0,
                 p.rpb + (size_t)(l * 6 + hh) * 465, pMIX + qrow * 1024 + hh * 64, smem);
      continue;
    }
    i -= n_nl;
    if (i < n_gc) {
      int b = i / 12, rem = i % 12, hq = rem / 2, qb = rem % 2, kvh = hq / 3;
      size_t qrow = (size_t)b * TPB + qb * 128 + w * 32;
      attn_block<true>(pBQ + qrow * 384 + hq * 64, 384, pBKK + (size_t)b * TPB * 128 + kvh * 64, 128,
                 pBVT + (size_t)(b * 2 + kvh) * 64 * TPB, 4, false, 0, 0, 0, 0, nullptr, pMIX + qrow * 1024 + 384 + hq * 64, smem, pMISC[l]);
      continue;
    }
    i -= n_gc;
    if (i < n_nc) {
      int b = i / 12, rem = i % 12, hh = rem / 2, qb = rem % 2;
      size_t qrow = (size_t)b * TPB + qb * 128 + w * 32;
      attn_block<false>(pAQ + qrow * 384 + hh * 64, 384, pAK + (size_t)b * TPB * 384 + hh * 64, 384,
                 pAVT + (size_t)(b * 6 + hh) * 64 * TPB, 4, false, 0, 0, 0, 0, nullptr, pMIX + qrow * 1024 + hh * 64, smem);
      continue;
    }
    i -= n_nc;
    {
      int b = i / 144, rem = i % 144, head = rem / 36, pos = rem % 36;
      h1_item(p, b, head, pos, smem);
    }
  }
}

DI void h3_phase(const P& p, int l, char* smem) {
  for (int it = obid(); it < 2304; it += gridDim.x) {
    int b = it / 144, rem = it % 144, head = rem / 36, pos = rem % 36;
    if (l == 3 && pos < 4) continue;
    h3_item(p, l, b, head, pos, smem);
  }
}


#if SELFCHECK
#define pFLAG ((unsigned*)(p.ws + O_FLAG))
DI float lb_ref(const P& p, int l, int dir, int c) {
  float v[4], mx = -1e30f, s = 0.f, acc = 0.f;
  for (int k = 0; k < 4; ++k) { v[k] = p.hlb[(k * 2 + dir) * 256 + c]; mx = fmaxf(mx, v[k]); }
  for (int k = 0; k < 4; ++k) { v[k] = expf(v[k] - mx); s += v[k]; }
  for (int k = 1; k <= l; ++k) acc += v[k] / s;
  return acc;
}
DI void chk_cmp(const P& p, float ref, float got, unsigned bit) {
  float e = wave_sum((ref - got) * (ref - got)), n = wave_sum(ref * ref);
  if (!(e <= 0.0009f * n + 1e-7f)) { if ((otid() & 63) == 0) atomicOr(pFLAG, bit); }
}
DI void chk_proj(const P& p, int l, int row, int g, int lane) {
  int b = row / TPB, tok = row - b * TPB;
  bool isctx = tok < 256;
  float z = 0.f;
  const float* wp = p.w_in + (size_t)l * 1024 * 3072 + 64 * g + lane;
  for (int k = 0; k < 1024; ++k) z += bf2f(pH[(size_t)row * 1024 + k]) * bf2f((u16)f2bf(wp[(size_t)k * 3072]));
  float ref = z, got;
  int t = tok - 256;
  auto nr = [&](const float* gw) {
    float ms = wave_sum(z * z) * (1.f / 64.f);
    float y = z * rsqrtf(ms + 1e-6f) * gw[lane];
    if (!isctx) {
      int axis = lane >> 5, pair = (lane >> 4) & 1, f = lane & 15;
      float other = __shfl(y, lane ^ 16);
      float pos = (float)(axis == 0 ? (t / 64) : (t % 64));
      float ang = pos * powf(10000.f, -(float)f / 16.f);
      float cs = cosf(ang), sn = sinf(ang);
      y = pair == 0 ? y * cs - other * sn : y * cs + other * sn;
    }
    return y;
  };
  if (g < 6) got = bf2f(pAK[(size_t)row * 384 + 64 * g + lane]);
  else if (g < 12) got = bf2f(pAVT[((size_t)(b * 6 + g - 6) * 64 + lane) * TPB + tok]);
  else if (g < 14) { ref = nr(p.kn + l * 64); got = bf2f(pBKK[(size_t)row * 128 + (g - 12) * 64 + lane]); }
  else if (g < 16) got = bf2f(pBVT[((size_t)(b * 2 + g - 14) * 64 + lane) * TPB + tok]);
  else if (g < 24) {
    int dir = g >= 20, c = (g - (dir ? 20 : 16)) * 64 + lane;
    float lb = lb_ref(p, l, dir, c);
    float sg = 1.f / (1.f + expf(-z));
    ref = logf(fmaxf(lb, 1e-30f) + (1.f - lb) * sg);
    got = pLOGF[(size_t)row * 512 + dir * 256 + c];
  } else if (g < 28) got = bf2f(pCI[(size_t)row * 256 + (g - 24) * 64 + lane]);
  else if (g < 34) { ref = z * 0.125f * LOG2E; got = bf2f(pAQ[(size_t)row * 384 + (g - 28) * 64 + lane]); }
  else if (g < 40) { ref = nr(p.qn + l * 64) * 0.125f * LOG2E; got = bf2f(pBQ[(size_t)row * 384 + (g - 34) * 64 + lane]); }
  else if (g < 44) { ref = z * 0.125f; got = bf2f(pCQ[(size_t)row * 256 + (g - 40) * 64 + lane]); }
  else got = bf2f(pCG[(size_t)row * 256 + (g - 44) * 64 + lane]);
  chk_cmp(p, ref, got, 1u);
}
DI void chk_attn(const P& p, int l, int kind, int b, int hh, int tok, int lane) {
  bool na = kind < 2, lat = (kind & 1) == 0;
  size_t row = (size_t)b * TPB + (lat ? 256 : 0) + tok;
  float q = na ? bf2f(pAQ[row * 384 + hh * 64 + lane]) : bf2f(pBQ[row * 384 + hh * 64 + lane]);
  float m = -1e30f, ls = 0.f, o = 0.f;
  auto key = [&](int j, float bias) {
    size_t krow = (size_t)b * TPB + j;
    float kv = na ? bf2f(pAK[krow * 384 + hh * 64 + lane]) : bf2f(pBKK[krow * 128 + (hh / 3) * 64 + lane]);
    float vv = na ? bf2f(pAVT[((size_t)(b * 6 + hh) * 64 + lane) * TPB + j]) : bf2f(pBVT[((size_t)(b * 2 + hh / 3) * 64 + lane) * TPB + j]);
    float s = wave_sum(q * kv) + bias * LOG2E;
    float mn = fmaxf(m, s), a = exp2f(m - mn), pr = exp2f(s - mn);
    ls = ls * a + pr; o = o * a + pr * vv; m = mn;
  };
  for (int j = 0; j < 256; ++j) key(j, 0.f);
  if (lat) {
    if (na) {
      int qr = tok / 64, qc = tok % 64;
      int rs = min(max(qr - 4, 0), 24), cs = min(max(qc - 8, 0), 48);
      for (int kr = rs; kr < rs + 8; ++kr)
        for (int kc = cs; kc < cs + 16; ++kc)
          key(256 + kr * 64 + kc, p.rpb[((size_t)(l * 6 + hh) * 15 + (kr - qr + 7)) * 31 + (kc - qc + 15)]);
    } else {
      for (int j = 256; j < TPB; ++j) key(j, 0.f);
    }
  }
  float got = bf2f(pMIX[row * 1024 + (na ? 0 : 384) + hh * 64 + lane]);
  chk_cmp(p, o / ls, got, na ? 2u : 4u);
}
DI void chk_hgrn(const P& p, int l, int b, int head, int i, char* smem) {
  const int tid = otid(), ch = tid >> 2, dv0 = (tid & 3) * 16;
  float* red = (float*)smem;
  if (tid < 64) red[tid] = 0.f;
  __syncthreads();
  for (int dir = 0; dir < 2; ++dir) {
    float S[16];
#pragma unroll
    for (int j = 0; j < 16; ++j) S[j] = 0.f;
    int nsteps = dir == 0 ? i + 1 : (i < 256 ? 256 - i : 256 + (TPB - i));
    for (int st = 0; st < nsteps; ++st) {
      int j;
      if (dir == 0) j = st;
      else j = i < 256 ? 255 - st : (st < 256 ? 255 - st : TPB - 1 - (st - 256));
      size_t rj = (size_t)b * TPB + j;
      float lf = pLOGF[rj * 512 + dir * 256 + head * 64 + ch];
      float f = expf(lf), k = -expm1f(lf);
#pragma unroll
      for (int jj = 0; jj < 16; ++jj) S[jj] = S[jj] * f + k * bf2f(pCI[rj * 256 + head * 64 + dv0 + jj]);
    }
    float q = bf2f(pCQ[((size_t)b * TPB + i) * 256 + head * 64 + ch]);
#pragma unroll
    for (int jj = 0; jj < 16; ++jj) atomicAdd(&red[dv0 + jj], q * S[jj]);
  }
  __syncthreads();
  if (tid < 64) {
    float o = red[tid];
    float ms = wave_sum(o * o) * (1.f / 64.f);
    size_t row = (size_t)b * TPB + i;
    float gg = bf2f(pCG[row * 256 + head * 64 + tid]);
    float ref = o * rsqrtf(ms + 1e-6f) * p.hgn[l * 64 + tid] * (gg / (1.f + expf(-gg)));
    float got = bf2f(pMIX[row * 1024 + 768 + head * 64 + tid]);
    chk_cmp(p, ref, got, 8u);
  }
  __syncthreads();
}
DI void selfcheck_proj(const P& p, int l) {
  const int lane = otid() & 63, gw = obid() * 4 + (otid() >> 6), nw = gridDim.x * 4;
  const int rows[6] = {5, TPB * 3 + 255, 256, TPB * 7 + 256 + 64 * 13 + 47, TPB * 15 + 2303, TPB * 9 + 256 + 63};
  for (int it = gw; it < 6 * 48; it += nw) {
    int ri = it / 48, g = it % 48;
    int row = ri == 0 ? rows[0] : ri == 1 ? rows[1] : ri == 2 ? rows[2] : ri == 3 ? rows[3] : ri == 4 ? rows[4] : rows[5];
    chk_proj(p, l, row, g, lane);
  }
}
DI void selfcheck_mix(const P& p, int l, char* smem) {
  const int lane = otid() & 63, gw = obid() * 4 + (otid() >> 6), nw = gridDim.x * 4;
  for (int it = gw; it < 21; it += nw) {
    if (it < 12) {
      int tk = it == 0 ? 0 : it == 1 ? 63 : it == 2 ? 1984 : it == 3 ? 2047 : it == 4 ? 327 : it == 5 ? 264 : it == 6 ? 1783 : it == 7 ? 1848 : it == 8 ? 1000 : it == 9 ? 37 : it == 10 ? 1056 : 252;
      chk_attn(p, l, 0, (it * 5) % 16, it % 6, tk, lane);
    } else if (it < 15) {
      int s = it - 12;
      chk_attn(p, l, 1, 2 + 4 * s, 1 + 2 * s, s == 0 ? 0 : s == 1 ? 100 : 255, lane);
    } else if (it < 19) {
      int s = it - 15;
      chk_attn(p, l, 2, s == 0 ? 1 : s == 1 ? 6 : s == 2 ? 12 : 15, s == 0 ? 0 : s == 1 ? 2 : s == 2 ? 3 : 5, s == 0 ? 0 : s == 1 ? 2047 : s == 2 ? 777 : 1285, lane);
    } else {
      int s = it - 19;
      chk_attn(p, l, 3, s == 0 ? 4 : 9, s == 0 ? 1 : 4, s == 0 ? 7 : 255, lane);
    }
  }
  for (int it = (int)gridDim.x - 1 - obid(); it < 8; it += gridDim.x) {
    int b = it == 0 ? 0 : it == 1 ? 3 : it == 2 ? 5 : it == 3 ? 8 : it == 4 ? 12 : it == 5 ? 15 : it == 6 ? 7 : 2;
    int hd = it & 3;
    int i = it == 0 ? 0 : it == 1 ? 255 : it == 2 ? 256 : it == 3 ? 319 : it == 4 ? 320 : it == 5 ? 2303 : it == 6 ? 1300 : 130;
    chk_hgrn(p, l, b, hd, i, smem);
  }
}
#endif

DI void prologue_a(const P& p, char* smem) {
  const int tid = otid();
  float* sc = (float*)smem;
  for (int it = obid(); it < 768; it += gridDim.x) {
    int cb = it % 24, s = (it / 24) % 8, l = it / 192;
    for (int idx = tid; idx < 17 * 128; idx += 256) {
      int rr = idx >> 7, kk = idx & 127, k = s * 128 + kk;
      float v = rr < 16 ? p.c[rr * 1024 + k] : p.c_ctx[k];
      sc[idx] = siluf(v);
    }
    __syncthreads();
    int n = cb * 256 + tid;
    float acc[17];
#pragma unroll
    for (int rr = 0; rr < 17; ++rr) acc[rr] = 0.f;
    const float* wp = p.w_ada + ((size_t)l * 1024 + s * 128) * 6144 + n;
#pragma unroll 1
    for (int k0 = 0; k0 < 128; k0 += 32) {
      float wv[32];
#pragma unroll
      for (int kk = 0; kk < 32; ++kk) wv[kk] = wp[(size_t)(k0 + kk) * 6144];
#pragma unroll
      for (int kk = 0; kk < 32; ++kk)
#pragma unroll
        for (int rr = 0; rr < 17; ++rr) acc[rr] += sc[rr * 128 + k0 + kk] * wv[kk];
    }
#pragma unroll
    for (int rr = 0; rr < 17; ++rr) pPART[((size_t)(s * 4 + l) * 17 + rr) * 6144 + n] = acc[rr];
    __syncthreads();
  }
  convert_weights(p, 0, 15, smem);
  if (obid() == 0) {
    for (int idx = tid; idx < 512; idx += 256) {
      float v0 = p.hlb[idx], v1 = p.hlb[512 + idx], v2 = p.hlb[1024 + idx], v3 = p.hlb[1536 + idx];
      float mx = fmaxf(fmaxf(v0, v1), fmaxf(v2, v3));
      float e0 = expf(v0 - mx), e1 = expf(v1 - mx), e2 = expf(v2 - mx), e3 = expf(v3 - mx);
      float inv = 1.f / (e0 + e1 + e2 + e3);
      pLB[idx] = 0.f;
      pLB[512 + idx] = e1 * inv;
      pLB[1024 + idx] = (e1 + e2) * inv;
      pLB[1536 + idx] = (e1 + e2 + e3) * inv;
    }
    if (tid < 4) {
      float mq = 0.f, mk = 0.f;
      for (int d = 0; d < 64; ++d) { mq = fmaxf(mq, fabsf(p.qn[tid * 64 + d])); mk = fmaxf(mk, fabsf(p.kn[tid * 64 + d])); }
      pMISC[tid] = 8.f * LOG2E * mq * mk;
    }
    for (int idx = tid; idx < 64 * 16; idx += 256) {
      int pos = idx >> 4, f = idx & 15;
      float invf = powf(10000.f, -(float)f / 16.f);
      float ang = (float)pos * invf;
      pROPE[pos * 32 + f] = cosf(ang);
      pROPE[pos * 32 + 16 + f] = sinf(ang);
    }
  }
}
DI void prologue_b(const P& p) {
  const int total = 4 * 17 * 6144;
  for (int idx = obid() * 256 + otid(); idx < total; idx += gridDim.x * 256) {
    int n = idx % 6144, lr = idx / 6144, l = lr / 17, rr = lr % 17;
    float a = p.b_ada[l * 6144 + n];
#pragma unroll
    for (int s = 0; s < 8; ++s) a += pPART[((size_t)(s * 4 + l) * 17 + rr) * 6144 + n];
    pMOD[idx] = a;
  }
}

__global__ void __launch_bounds__(256, 2) mega(P p) {
  cg::grid_group grid = cg::this_grid();
  __shared__ __attribute__((aligned(16))) char smem[SMEM_BYTES];
  __shared__ uint4 xb_words;
  if (threadIdx.x == 0) xb_words = make_uint4(0u, 0u, 0u, 0u);
  __syncthreads();
  (void)xcd_barrier_post((unsigned*)(p.ws + O_BAR), (volatile LAS unsigned*)&xb_words);
#define XBAR() do { XcdBarrier xb_; xb_.bar = (unsigned*)(p.ws + O_BAR); xb_.x = xb_xcc_id(); xb_.st = (volatile LAS unsigned*)&xb_words; xcd_barrier(xb_); } while (0)
#if SELFCHECK
  if (obid() == 0 && otid() == 0) *((unsigned*)(p.ws + O_FLAG)) = 0u;
#endif
  prologue_a(p, smem);
  if (p.ws == nullptr) grid.sync();
  XBAR();
  prologue_b(p);
  XBAR();
  ln_phase(p, 0, 0);
  XBAR();
#pragma unroll 1
  for (int l = 0; l < 4; ++l) {
    proj_phase(p, l, smem);
    XBAR();
#if SELFCHECK
    if (l < 2) { selfcheck_proj(p, l); XBAR(); }
#endif
    attn_phase(p, l, smem);
    XBAR();
    h2_phase(p);
    XBAR();
    h3_phase(p, l, smem);
    XBAR();
#if SELFCHECK
    if (l < 2) { selfcheck_mix(p, l, smem); XBAR(); }
#endif
    res_gemm_phase(p, l, pWoutT, pMIX, 1024, 2, smem);
    XBAR();
    ln_phase(p, 1, l);
    XBAR();
    up_phase(p, l, smem);
    XBAR();
    fixup_phase(p, l);
    if (l < 3) convert_weights(p, l + 1, 7, smem);
    XBAR();
    res_gemm_phase(p, l, pWdownT, pACT, DFF, 5, smem);
    XBAR();
    ln_phase(p, 2, l);
    if (l < 3) convert_weights(p, l + 1, 8, smem);
    XBAR();
  }
}

extern "C" void kernel_launch(void* const* d_in, const int* in_sizes, int n_in, void* d_out, int out_size, void* d_ws,
                              size_t ws_size, hipStream_t stream) {
  P p{};
  p.x = (const float*)d_in[0]; p.c = (const float*)d_in[1]; p.ctx = (const float*)d_in[2]; p.c_ctx = (const float*)d_in[3];
  p.w_ada = (const float*)d_in[4]; p.b_ada = (const float*)d_in[5]; p.w_in = (const float*)d_in[6]; p.w_out = (const float*)d_in[7];
  p.rpb = (const float*)d_in[8]; p.qn = (const float*)d_in[9]; p.kn = (const float*)d_in[10]; p.hlb = (const float*)d_in[11];
  p.hgn = (const float*)d_in[12]; p.ln1g = (const float*)d_in[13]; p.ln1b = (const float*)d_in[14]; p.w_up = (const float*)d_in[15];
  p.conv_w = (const float*)d_in[16]; p.conv_b = (const float*)d_in[17]; p.w_down = (const float*)d_in[18];
  p.ln2g = (const float*)d_in[19]; p.ln2b = (const float*)d_in[20];
  p.out = (float*)d_out;
  p.ws = (char*)d_ws;
  if (O_TOTAL > ws_size) fprintf(stderr, "workspace too small: need %zu have %zu\n", (size_t)O_TOTAL, ws_size);

  hipMemsetAsync((char*)d_ws + O_BAR, 0, 16384, stream);
  static int grid_blocks = 0;
  if (!grid_blocks) {
    int dev = 0, cus = 0, per_cu = 0;
    hipGetDevice(&dev);
    hipDeviceGetAttribute(&cus, hipDeviceAttributeMultiprocessorCount, dev);
    hipOccupancyMaxActiveBlocksPerMultiprocessor(&per_cu, mega, 256, 0);
    if (per_cu > 2) per_cu = 2;
    if (per_cu < 1) per_cu = 1;
    grid_blocks = (cus * per_cu) & ~7;
  }
  void* args[] = {&p};
  hipError_t e = hipLaunchCooperativeKernel((void*)mega, dim3(grid_blocks), dim3(256), args, 0, stream);
  if (e != hipSuccess) fprintf(stderr, "cooperative launch failed: %s (grid %d)\n", hipGetErrorString(e), grid_blocks);
}
```
